# Optimizing an MI355X kernel written in HIP

```python
import jax, jax.numpy as jnp
from jax import lax
import numpy as np

D_MODEL = 1024
BATCH = 2
SEQ = 16384
DEPTH = 2

GRID_W = 64
CTX_LEN = 256
NA_HEADS = 8
HEAD_DIM = 64
NA_WIDTH = NA_HEADS * HEAD_DIM
WIN_H = 8
WIN_W = 16
SG_GROUPS = 4
SG_CHUNK = 128
SG_WIDTH = 512
D_FF = 2816
ROPE_THETA = 10000.0
EPS = 1e-6
N_MOD = 9
Q0, K0, V0 = 0, NA_WIDTH, 2 * NA_WIDTH
U0 = 3 * NA_WIDTH
VS0 = U0 + SG_WIDTH
G0 = VS0 + SG_WIDTH
IN_COLS = G0 + 2 * D_MODEL

kernel_name = "hybrid_na_gmlp_macaron_dit"


def rmsnorm(t, g):
    tf = t.astype(jnp.float32)
    y = tf * lax.rsqrt(jnp.mean(tf * tf, axis=-1, keepdims=True) + EPS)
    return (y * g.astype(jnp.float32)).astype(t.dtype)


def layernorm(t, g, b):
    tf = t.astype(jnp.float32)
    mu = jnp.mean(tf, axis=-1, keepdims=True)
    var = jnp.mean(jnp.square(tf - mu), axis=-1, keepdims=True)
    y = (tf - mu) * lax.rsqrt(var + EPS)
    return (y * g.astype(jnp.float32) + b.astype(jnp.float32)).astype(t.dtype)


def modulate(t, g, shift, scale):
    return rmsnorm(t, g) * (1.0 + scale) + shift


def ada_mod(cond, w, b):
    m = jax.nn.silu(cond) @ w + b
    return jnp.moveaxis(m.reshape(cond.shape[0], N_MOD, D_MODEL), 1, 0)[:, :, None, :]


def swiglu(h, w_up, w_down):
    a, b = jnp.split(h @ w_up, 2, axis=-1)
    return (jax.nn.silu(a) * b) @ w_down


def ffn_sublayer(t, mod, i, g, w_up, w_down):
    h = modulate(t, g, mod[3 * i], mod[3 * i + 1])
    return t + 0.5 * mod[3 * i + 2] * swiglu(h, w_up, w_down)


def heads(t):
    return t.reshape(*t.shape[:-1], NA_HEADS, HEAD_DIM)


def axial_rope(t, rows, cols):
    n_freq = HEAD_DIM // 4
    freqs = ROPE_THETA ** (-jnp.arange(n_freq, dtype=jnp.float32) / n_freq)
    ang = jnp.concatenate([rows[:, None] * freqs, cols[:, None] * freqs], axis=-1)
    cos = jnp.cos(ang)[None, :, None, :]
    sin = jnp.sin(ang)[None, :, None, :]
    tf = t.astype(jnp.float32).reshape(*t.shape[:-1], HEAD_DIM // 2, 2)
    e, o = tf[..., 0], tf[..., 1]
    out = jnp.stack([e * cos - o * sin, e * sin + o * cos], axis=-1).reshape(t.shape)
    return out.astype(t.dtype)


def neighbourhood_attention(q, k, v, k_ctx, v_ctx, rpb):
    B, N, H, hd = q.shape
    rows = N // GRID_W
    win_h = min(WIN_H, rows)
    n_nb = win_h * WIN_W
    scale = hd ** -0.5
    qg = q.reshape(B, rows, GRID_W, H, hd)
    kg = k.reshape(B, rows, GRID_W, H, hd)
    vg = v.reshape(B, rows, GRID_W, H, hd)
    cols = jnp.arange(GRID_W)
    col_start = jnp.clip(cols - WIN_W // 2, 0, GRID_W - WIN_W)
    col_idx = col_start[:, None] + jnp.arange(WIN_W)[None, :]
    dc = col_idx - cols[:, None] + (WIN_W - 1)
    rpb_c = rpb[:, :, dc]

    def row_block(r):
        rs = jnp.clip(r - WIN_H // 2, 0, rows - win_h)
        q_r = lax.dynamic_index_in_dim(qg, r, axis=1, keepdims=False)
        k_rows = lax.dynamic_slice_in_dim(kg, rs, win_h, axis=1)
        v_rows = lax.dynamic_slice_in_dim(vg, rs, win_h, axis=1)
        k_nb = jnp.moveaxis(k_rows[:, :, col_idx], 2, 1).reshape(B, GRID_W, n_nb, H, hd)
        v_nb = jnp.moveaxis(v_rows[:, :, col_idx], 2, 1).reshape(B, GRID_W, n_nb, H, hd)
        dr = rs + jnp.arange(win_h) - r + (WIN_H - 1)
        bias = jnp.moveaxis(jnp.take(rpb_c, dr, axis=1), 2, 1).reshape(H, GRID_W, n_nb)
        s_nb = jnp.einsum('bqhd,bqkhd->bhqk', q_r, k_nb).astype(jnp.float32) * scale \
            + bias.astype(jnp.float32)
        s_ctx = jnp.einsum('bqhd,bkhd->bhqk', q_r, k_ctx).astype(jnp.float32) * scale
        p = jax.nn.softmax(jnp.concatenate([s_nb, s_ctx], axis=-1), axis=-1).astype(v.dtype)
        return (jnp.einsum('bhqk,bqkhd->bqhd', p[..., :n_nb], v_nb)
                + jnp.einsum('bhqk,bkhd->bqhd', p[..., n_nb:], v_ctx))

    out = lax.map(row_block, jnp.arange(rows))
    return jnp.moveaxis(out, 0, 1).reshape(B, N, H * hd)


def context_attention(q, k, v):
    B, L, H, hd = q.shape
    s = jnp.einsum('bqhd,bkhd->bhqk', q, k).astype(jnp.float32) * (hd ** -0.5)
    p = jax.nn.softmax(s, axis=-1).astype(v.dtype)
    return jnp.einsum('bhqk,bkhd->bqhd', p, v).reshape(B, L, H * hd)


def chunk_spatial_gating(u, v, ln_g, ln_b, w_s, b_s):
    B, N, _ = v.shape
    vn = layernorm(v, ln_g, ln_b).reshape(B, N // SG_CHUNK, SG_CHUNK, SG_GROUPS, SG_WIDTH // SG_GROUPS)
    s = jnp.einsum('gpq,bnqgc->bnpgc', w_s, vn) + b_s.T[None, None, :, :, None]
    return u * s.reshape(B, N, SG_WIDTH)


def merge_branches(o_a, o_b, g_logits, b_gate, w_pa, w_pb, w_o):
    g_a, g_b = jnp.split(jax.nn.sigmoid(g_logits + b_gate), 2, axis=-1)
    return (g_a * (o_a @ w_pa) + g_b * (o_b @ w_pb)) @ w_o


def setup_inputs(seed: int = 0) -> dict:
    key = jax.random.key(seed)
    ks = jax.random.split(key, 24)
    f32 = jnp.float32
    nrm = lambda k, shape, s: jax.random.normal(k, shape, f32) * s
    D, L = D_MODEL, DEPTH
    return {
        "x": nrm(ks[0], (BATCH, SEQ, D), 1.0),
        "c": nrm(ks[1], (BATCH, D), 1.0),
        "ctx": nrm(ks[2], (BATCH, CTX_LEN, D), 1.0),
        "c_ctx": nrm(ks[3], (D,), 1.0),
        "w_ada": nrm(ks[4], (L, D, N_MOD * D), 0.5 * D ** -0.5),
        "b_ada": nrm(ks[5], (L, N_MOD * D), 0.02),
        "norm_g": 1.0 + nrm(ks[6], (L, 3, D), 0.02),
        "w_ff1_up": nrm(ks[7], (L, D, 2 * D_FF), D ** -0.5),
        "w_ff1_down": nrm(ks[8], (L, D_FF, D), D_FF ** -0.5),
        "w_in": nrm(ks[9], (L, D, IN_COLS), D ** -0.5),
        "b_gate": nrm(ks[10], (L, 2 * D), 0.02),
        "rpb": nrm(ks[11], (L, NA_HEADS, 2 * WIN_H - 1, 2 * WIN_W - 1), 0.1),
        "ln_v_g": 1.0 + nrm(ks[12], (L, SG_WIDTH), 0.02),
        "ln_v_b": nrm(ks[13], (L, SG_WIDTH), 0.02),
        "w_s": nrm(ks[14], (L, SG_GROUPS, SG_CHUNK, SG_CHUNK), 0.5 * SG_CHUNK ** -0.5),
        "b_s": 1.0 + nrm(ks[15], (L, SG_GROUPS, SG_CHUNK), 0.02),
        "w_pa": nrm(ks[16], (L, NA_WIDTH, D), NA_WIDTH ** -0.5),
        "w_pb": nrm(ks[17], (L, SG_WIDTH, D), SG_WIDTH ** -0.5),
        "w_o": nrm(ks[18], (L, D, D), D ** -0.5),
        "w_ff2_up": nrm(ks[19], (L, D, 2 * D_FF), D ** -0.5),
        "w_ff2_down": nrm(ks[20], (L, D_FF, D), D_FF ** -0.5),
        "final_g": 1.0 + nrm(ks[21], (D,), 0.02),
    }


def reference(x, c, ctx, c_ctx, w_ada, b_ada, norm_g, w_ff1_up, w_ff1_down, w_in, b_gate,
              rpb, ln_v_g, ln_v_b, w_s, b_s, w_pa, w_pb, w_o, w_ff2_up, w_ff2_down, final_g):
    N = x.shape[1]
    t = jnp.arange(N)
    pos_r = (t // GRID_W).astype(jnp.float32)
    pos_c = (t % GRID_W).astype(jnp.float32)
    gelu = jax.nn.gelu

    for l in range(DEPTH):
        last = l == DEPTH - 1
        mx = ada_mod(c, w_ada[l], b_ada[l])
        mc = ada_mod(c_ctx[None, :], w_ada[l], b_ada[l])

        x = ffn_sublayer(x, mx, 0, norm_g[l, 0], w_ff1_up[l], w_ff1_down[l])
        ctx = ffn_sublayer(ctx, mc, 0, norm_g[l, 0], w_ff1_up[l], w_ff1_down[l])

        hx = modulate(x, norm_g[l, 1], mx[3], mx[4])
        hc = modulate(ctx, norm_g[l, 1], mc[3], mc[4])
        px = hx @ w_in[l]
        if last:
            pc = hc @ w_in[l][:, K0:U0]
            kc, vc = heads(pc[..., :NA_WIDTH]), heads(pc[..., NA_WIDTH:])
        else:
            pc = hc @ w_in[l]
            kc, vc = heads(pc[..., K0:V0]), heads(pc[..., V0:U0])

        qx = axial_rope(heads(px[..., Q0:K0]), pos_r, pos_c)
        kx = axial_rope(heads(px[..., K0:V0]), pos_r, pos_c)
        o_a = neighbourhood_attention(qx, kx, heads(px[..., V0:U0]), kc, vc, rpb[l])
        o_b = chunk_spatial_gating(gelu(px[..., U0:VS0]), gelu(px[..., VS0:G0]),
                                   ln_v_g[l], ln_v_b[l], w_s[l], b_s[l])
        x = x + mx[5] * merge_branches(o_a, o_b, px[..., G0:], b_gate[l], w_pa[l], w_pb[l], w_o[l])

        if not last:
            o_ac = context_attention(heads(pc[..., Q0:K0]), kc, vc)
            o_bc = chunk_spatial_gating(gelu(pc[..., U0:VS0]), gelu(pc[..., VS0:G0]),
                                        ln_v_g[l], ln_v_b[l], w_s[l], b_s[l])
            ctx = ctx + mc[5] * merge_branches(o_ac, o_bc, pc[..., G0:], b_gate[l],
                                               w_pa[l], w_pb[l], w_o[l])
            ctx = ffn_sublayer(ctx, mc, 2, norm_g[l, 2], w_ff2_up[l], w_ff2_down[l])

        x = ffn_sublayer(x, mx, 2, norm_g[l, 2], w_ff2_up[l], w_ff2_down[l])

    return rmsnorm(x, final_g)
```

```cpp
#include <hip/hip_runtime.h>
#include <hip/hip_cooperative_groups.h>
#include <cstdio>
#include <cstdint>
#include <cmath>
namespace pg8 {
#define PG8_LAS __attribute__((address_space(3)))
typedef unsigned short bf16_t;
typedef short bf16x8 __attribute__((ext_vector_type(8)));
typedef float f32x4 __attribute__((ext_vector_type(4)));
typedef unsigned u32x4 __attribute__((ext_vector_type(4)));
constexpr int BM = 256, BK = 64, HALF = 128, HTB = HALF * BK * 2  , STAGE_BYTES = 8 * HTB, NXCD = 8, WGM = 4;

__host__ __device__ __forceinline__ int lds_byte(int r, int c) { const int st = (r >> 4) * 2 + (c >> 5), rr = r & 15, cc = c & 31, ob = rr * 64 + cc * 2; return st * 1024 + (ob ^ (((ob >> 9) & 1) << 5)); }
__host__ __device__ __forceinline__ void stage_rc(int b, int& R, int& C) { const int st = b / 1024, sb = b % 1024, swz = sb ^ (((sb >> 9) & 1) << 5); R = (st >> 1) * 16 + swz / 64; C = (st & 1) * 32 + (swz % 64) / 2; }
__host__ __device__ __forceinline__ int perm32(int rho) { const int n = rho >> 4, i = rho & 15; return 8 * (i >> 2) + 4 * n + (i & 3); }

struct Unit { int pm, pn; };
struct Gemm { const bf16_t* A; const bf16_t* Bt; int M, N, K; };

struct StaticOrder {
    int nM, nN, nwg, G, c;
    __host__ __device__ void init(int M, int N, int G_, int c_) { nM = M / BM; nN = N / BM; nwg = nM * nN; G = G_; c = c_; }
    __host__ __device__ bool next(int i, Unit& u) const {
        const long L = (long)i * G + c; if (L >= nwg) return false;
        int wgid = (int)L; { const int q = nwg / NXCD, r = nwg % NXCD, xcd = wgid % NXCD, off = wgid / NXCD; wgid = (xcd < r ? xcd * (q + 1) : r * (q + 1) + (xcd - r) * q) + off; }
        const int nig = WGM * nN, gid = wgid / nig, fm = gid * WGM, gsz = (nM - fm) < WGM ? (nM - fm) : WGM;
        u.pm = fm + ((wgid % nig) % gsz); u.pn = (wgid % nig) / gsz; return true;
    }
    __device__ __forceinline__ void a_ready(const Unit&) const {}
    __device__ __forceinline__ void done(const Unit&) const {}
};

__device__ __forceinline__ unsigned cvt_pk_bf16(float lo, float hi) { unsigned r; asm volatile("v_cvt_pk_bf16_f32 %0, %1, %2" : "=v"(r) : "v"(lo), "v"(hi)); return r; }
constexpr int D_ = 1024, MX_ = 32768, MALL_ = 33280, DFF_ = 2816;
typedef float f32x2 __attribute__((ext_vector_type(2)));
__device__ __forceinline__ float fast_sigmoid(float x) { return __builtin_amdgcn_rcpf(1.0f + __builtin_amdgcn_exp2f(-1.4426950408889634f * x)); }
__device__ __forceinline__ float silu_f(float x) { return x * fast_sigmoid(x); }
__device__ __forceinline__ float gelu_tanh(float x) { const float u = 1.5957691216057308f * (x + 0.044715f * x * x * x); return x * fast_sigmoid(u); }
__device__ __forceinline__ float bf2f(unsigned short b) { return __uint_as_float(((unsigned)b) << 16); }
__device__ __forceinline__ float bflo(unsigned w) { return __uint_as_float(w << 16); }
__device__ __forceinline__ float bfhi(unsigned w) { return __uint_as_float(w & 0xffff0000u); }
__device__ __forceinline__ unsigned short f2bf_rne(float f) { unsigned u = __float_as_uint(f); return (unsigned short)((u + 0x7fffu + ((u >> 16) & 1u)) >> 16); }

__device__ __forceinline__ u32x4 quad_swap(unsigned lo0, unsigned lo1, unsigned hi0, unsigned hi1, int fq, int& coloff) {
    const bool odd = fq & 1;
    const unsigned s0 = odd ? lo0 : hi0, s1 = odd ? lo1 : hi1;
    const unsigned r0 = (unsigned)__shfl_xor((int)s0, 16), r1 = (unsigned)__shfl_xor((int)s1, 16);
    coloff = odd ? 16 + 4 * (fq - 1) : 4 * fq;
    u32x4 o; o.x = odd ? r0 : lo0; o.y = odd ? r1 : lo1; o.z = odd ? hi0 : r0; o.w = odd ? hi1 : r1; return o;
}

struct EpiSwiGLU {
    static constexpr bool PERM = true, AFTER_DRAIN = false;
    bf16_t* O;
    __device__ __forceinline__ void operator()(const f32x4 (&acc)[2][2][4][2], const Unit& u, int wr, int wc, int fr, int fq) const {
        const int row0 = u.pm * BM + wr * 64 + fr, col0 = u.pn * HALF + wc * 32 + 8 * fq;
#pragma unroll
        for (int ai = 0; ai < 2; ++ai)
#pragma unroll
            for (int m = 0; m < 4; ++m) {
                bf16_t* p = O + (size_t)(row0 + ai * HALF + m * 16) * DFF_ + col0;
                const f32x4 a0 = acc[ai][0][m][0], a1 = acc[ai][0][m][1], b0 = acc[ai][1][m][0], b1 = acc[ai][1][m][1];
                float h[8];
#pragma unroll
                for (int e = 0; e < 4; ++e) { h[e] = silu_f(a0[e]) * b0[e]; h[4 + e] = silu_f(a1[e]) * b1[e]; }
                u32x4 w; w.x = cvt_pk_bf16(h[0], h[1]); w.y = cvt_pk_bf16(h[2], h[3]); w.z = cvt_pk_bf16(h[4], h[5]); w.w = cvt_pk_bf16(h[6], h[7]);
                *(u32x4*)p = w;
            }
    }
};

struct EpiResid {
    static constexpr bool PERM = false, AFTER_DRAIN = false;
    const float* src_main; const float* src_ctx; float* dst_main; float* dst_ctx; const float* gate_l  ; float coef;
    __device__ __forceinline__ void operator()(const f32x4 (&acc)[2][2][4][2], const Unit& u, int wr, int wc, int fr, int fq) const {
        const int cond = u.pm < 64 ? 0 : (u.pm < 128 ? 1 : 2);
        const float* gate = gate_l + cond * 9216;
        const int col0 = u.pn * BM + wc * 32 + 4 * fq;
        f32x4 gv[2][2];
#pragma unroll
        for (int bj = 0; bj < 2; ++bj)
#pragma unroll
            for (int n = 0; n < 2; ++n) gv[bj][n] = *(const f32x4*)(gate + col0 + bj * HALF + n * 16) * coef;
#pragma unroll
        for (int ai = 0; ai < 2; ++ai)
#pragma unroll
            for (int m = 0; m < 4; ++m) {
                const int row = u.pm * BM + ai * HALF + wr * 64 + m * 16 + fr;
                const float* s = row < MX_ ? src_main + (size_t)row * D_ : src_ctx + (size_t)(row - MX_) * D_;
                float* d = row < MX_ ? dst_main + (size_t)row * D_ : dst_ctx + (size_t)(row - MX_) * D_;
#pragma unroll
                for (int bj = 0; bj < 2; ++bj)
#pragma unroll
                    for (int n = 0; n < 2; ++n) { const int off = col0 + bj * HALF + n * 16; const f32x4 xo = *(const f32x4*)(s + off); *(f32x4*)(d + off) = xo + gv[bj][n] * acc[ai][bj][m][n]; }
            }
    }
};

struct EpiWin {
    static constexpr bool PERM = true, AFTER_DRAIN = false;
    bf16_t *QU, *KB, *VT, *VST, *GT; const float* bgate; const f32x4* ropeR; const f32x4* ropeC; float* stats; float qscale; PG8_LAS unsigned char* tl  ;
    __device__ __forceinline__ void operator()(const f32x4 (&acc)[2][2][4][2], const Unit& u, int wr, int wc, int fr, int fq) const {
        const int pn = u.pn, rowbase = u.pm * BM + wr * 64 + fr, cl = wc * 32 + 8 * fq;
        if (pn < 4) {
            const bool isq = pn < 2; bf16_t* O = isq ? QU : KB; const int ldo = isq ? 1024 : 512; const int cb = (pn & 1) * 256;
            const bool dorope = u.pm < 128; const float sc = isq ? qscale : 1.0f;
#pragma unroll
            for (int ai = 0; ai < 2; ++ai)
#pragma unroll
                for (int m = 0; m < 4; ++m) {
                    const int row = rowbase + ai * HALF + m * 16; const int t = row & 16383; const int pos = (wc & 1) ? (t & 63) : (t >> 6);
                    const f32x4* tab = ((wc & 1) ? ropeC : ropeR) + pos * 8 + 2 * fq;
                    f32x4 cs0 = (f32x4){1.f, 0.f, 1.f, 0.f}, cs1 = cs0;
                    if (dorope) { cs0 = tab[0]; cs1 = tab[1]; }
#pragma unroll
                    for (int bj = 0; bj < 2; ++bj) {
                        const f32x4 v0 = acc[ai][bj][m][0], v1 = acc[ai][bj][m][1];
                        float o[8];
                        o[0] = v0[0] * cs0[0] - v0[1] * cs0[1]; o[1] = v0[0] * cs0[1] + v0[1] * cs0[0];
                        o[2] = v0[2] * cs0[2] - v0[3] * cs0[3]; o[3] = v0[2] * cs0[3] + v0[3] * cs0[2];
                        o[4] = v1[0] * cs1[0] - v1[1] * cs1[1]; o[5] = v1[0] * cs1[1] + v1[1] * cs1[0];
                        o[6] = v1[2] * cs1[2] - v1[3] * cs1[3]; o[7] = v1[2] * cs1[3] + v1[3] * cs1[2];
                        u32x4 w; w.x = cvt_pk_bf16(o[0] * sc, o[1] * sc); w.y = cvt_pk_bf16(o[2] * sc, o[3] * sc); w.z = cvt_pk_bf16(o[4] * sc, o[5] * sc); w.w = cvt_pk_bf16(o[6] * sc, o[7] * sc);
                        const int cq = cb + bj * HALF + cl;
                        if (isq) *(u32x4*)(O + (size_t)row * 1024 + cq) = w;
                        else *(u32x4*)(O + ((size_t)(cq >> 6) * MALL_ + row) * 64 + (cq & 63)) = w;
                    }
                }
        } else if (pn < 6 || pn == 8 || pn == 9) {
            const bool isv = pn < 6; bf16_t* O = isv ? VT : VST; const int cb = (pn & 1) * 256;
            PG8_LAS unsigned char* T = tl + (wr * 4 + wc) * 2048;
            const int lane = fq * 16 + fr;
#pragma unroll
            for (int ai = 0; ai < 2; ++ai)
#pragma unroll
                for (int m = 0; m < 4; ++m) {
                    const int row = rowbase + ai * HALF + m * 16; float s1 = 0.f, s2 = 0.f;
#pragma unroll
                    for (int bj = 0; bj < 2; ++bj)
#pragma unroll
                        for (int n = 0; n < 2; ++n)
#pragma unroll
                            for (int e = 0; e < 4; ++e) {
                                float v = acc[ai][bj][m][n][e]; if (!isv) v = gelu_tanh(v);
                                const unsigned short b = f2bf_rne(v); const float vr = bf2f(b); s1 += vr; s2 += vr * vr;
                                *(PG8_LAS unsigned short*)(T + (bj * 32 + fq * 8 + n * 4 + e) * 32 + fr * 2) = b;
                            }
                    const int row16 = row - fr;
                    asm volatile("" ::: "memory");
#pragma unroll
                    for (int k = 0; k < 2; ++k) {
                        const int p = lane + 64 * k, cidx = p >> 1, half = p & 1;
                        const u32x4 w = *(const PG8_LAS u32x4*)(T + cidx * 32 + half * 16);
                        *(u32x4*)(O + ((size_t)((row16 >> 3) + half) * 512 + (cb + 128 * (cidx >> 5) + 32 * wc + (cidx & 31))) * 8) = w;
                    }
                    asm volatile("" ::: "memory");
                    if (!isv) {
                        s1 += __shfl_xor(s1, 16); s1 += __shfl_xor(s1, 32); s2 += __shfl_xor(s2, 16); s2 += __shfl_xor(s2, 32);
                        if (fq == 0) { unsafeAtomicAdd(stats + 2 * row, s1); unsafeAtomicAdd(stats + 2 * row + 1, s2); }
                    }
                }
        } else if (pn < 8) {
            const int cb = 512 + (pn - 6) * 256;
#pragma unroll
            for (int ai = 0; ai < 2; ++ai)
#pragma unroll
                for (int m = 0; m < 4; ++m) {
                    const int row = rowbase + ai * HALF + m * 16;
#pragma unroll
                    for (int bj = 0; bj < 2; ++bj) {
                        const f32x4 v0 = acc[ai][bj][m][0], v1 = acc[ai][bj][m][1];
                        u32x4 w; w.x = cvt_pk_bf16(gelu_tanh(v0[0]), gelu_tanh(v0[1])); w.y = cvt_pk_bf16(gelu_tanh(v0[2]), gelu_tanh(v0[3]));
                        w.z = cvt_pk_bf16(gelu_tanh(v1[0]), gelu_tanh(v1[1])); w.w = cvt_pk_bf16(gelu_tanh(v1[2]), gelu_tanh(v1[3]));
                        *(u32x4*)(QU + (size_t)row * 1024 + cb + bj * HALF + cl) = w;
                    }
                }
        } else {
            const int cb = (pn - 10) * 256;
            f32x4 bg[2][2];
#pragma unroll
            for (int bj = 0; bj < 2; ++bj)
#pragma unroll
                for (int n = 0; n < 2; ++n) bg[bj][n] = *(const f32x4*)(bgate + cb + bj * HALF + cl + 4 * n);
#pragma unroll
            for (int ai = 0; ai < 2; ++ai)
#pragma unroll
                for (int m = 0; m < 4; ++m) {
                    const int row = rowbase + ai * HALF + m * 16;
#pragma unroll
                    for (int bj = 0; bj < 2; ++bj) {
                        const f32x4 v0 = acc[ai][bj][m][0] + bg[bj][0], v1 = acc[ai][bj][m][1] + bg[bj][1];
                        u32x4 w; w.x = cvt_pk_bf16(fast_sigmoid(v0[0]), fast_sigmoid(v0[1])); w.y = cvt_pk_bf16(fast_sigmoid(v0[2]), fast_sigmoid(v0[3]));
                        w.z = cvt_pk_bf16(fast_sigmoid(v1[0]), fast_sigmoid(v1[1])); w.w = cvt_pk_bf16(fast_sigmoid(v1[2]), fast_sigmoid(v1[3]));
                        *(u32x4*)(GT + (size_t)row * 2048 + cb + bj * HALF + cl) = w;
                    }
                }
        }
    }
};

struct EpiMerge {
    static constexpr bool PERM = true, AFTER_DRAIN = false;
    const bf16_t* GT; bf16_t* MRG;
    __device__ __forceinline__ void operator()(const f32x4 (&acc)[2][2][4][2], const Unit& u, int wr, int wc, int fr, int fq) const {
        const int row0 = u.pm * BM + wr * 64 + fr, col0 = u.pn * HALF + wc * 32 + 8 * fq;
#pragma unroll
        for (int ai = 0; ai < 2; ++ai)
#pragma unroll
            for (int m = 0; m < 4; ++m) {
                const int row = row0 + ai * HALF + m * 16;
                const u32x4 ga = *(const u32x4*)(GT + (size_t)row * 2048 + col0), gb = *(const u32x4*)(GT + (size_t)row * 2048 + 1024 + col0);
                const f32x4 a0 = acc[ai][0][m][0], a1 = acc[ai][0][m][1], b0 = acc[ai][1][m][0], b1 = acc[ai][1][m][1];
                u32x4 w;
                w.x = cvt_pk_bf16(bflo(ga.x) * a0[0] + bflo(gb.x) * b0[0], bfhi(ga.x) * a0[1] + bfhi(gb.x) * b0[1]);
                w.y = cvt_pk_bf16(bflo(ga.y) * a0[2] + bflo(gb.y) * b0[2], bfhi(ga.y) * a0[3] + bfhi(gb.y) * b0[3]);
                w.z = cvt_pk_bf16(bflo(ga.z) * a1[0] + bflo(gb.z) * b1[0], bfhi(ga.z) * a1[1] + bfhi(gb.z) * b1[1]);
                w.w = cvt_pk_bf16(bflo(ga.w) * a1[2] + bflo(gb.w) * b1[2], bfhi(ga.w) * a1[3] + bfhi(gb.w) * b1[3]);
                *(u32x4*)(MRG + (size_t)row * 1024 + col0) = w;
            }
    }
};

template <class Epi, class Sched, bool ALIGN_EPI = false, bool SP2 = false>
__device__ __forceinline__ void gemm_phase(PG8_LAS unsigned char* lds, const Gemm g, const Sched& S, const Epi& E) {
    int tid_ = threadIdx.x; asm volatile("" : "+v"(tid_));
    const int tid = tid_, wid = __builtin_amdgcn_readfirstlane(tid >> 6), lane = tid & 63, wr = wid >> 2, wc = wid & 3, fr = lane & 15, fq = lane >> 4;
    const int K = g.K, nt = K / BK;
    unsigned voffA[2], voffB[2];
#pragma unroll
    for (int i = 0; i < 2; ++i) { int R, C; stage_rc(tid * 16 + i * 8192, R, C); const int Rb = Epi::PERM ? ((R & ~31) + perm32(R & 31)) : R;
        voffA[i] = (unsigned)(R * K + C) * 2u; voffB[i] = (unsigned)(Rb * K + C) * 2u; }
    const size_t kstep = (size_t)(BK * 2);
    const size_t hstep = (size_t)HALF * K * 2;
    const size_t tstep = 2 * hstep;
    const unsigned ldsw = (unsigned)wid * 1024u;
    const int aoff = lds_byte(wr * 64 + fr, fq * 8), boff = lds_byte(wc * 32 + fr, fq * 8);
#define PG8_SA(b, h) (((b) * 2 + (h)) * HTB)
#define PG8_SB(b, h) ((4 + (b) * 2 + (h)) * HTB)
#define PG8_STAGE(bufoff, gbase, voff) do { _Pragma("unroll") for (int _i = 0; _i < 2; ++_i) \
        __builtin_amdgcn_global_load_lds((const unsigned*)((const char*)(gbase) + (voff)[_i]), (PG8_LAS unsigned*)(lds + (bufoff) + ldsw + _i * 8192), 16, 0, 0); } while (0)
#define PG8_LDA(dst, b, h) do { _Pragma("unroll") for (int m = 0; m < 4; ++m) _Pragma("unroll") for (int k = 0; k < 2; ++k) dst[m][k] = *(const PG8_LAS bf16x8*)(lds + PG8_SA(b, h) + aoff + m * 2048 + k * 1024); } while (0)
#define PG8_LDB(dst, b, h) do { _Pragma("unroll") for (int n = 0; n < 2; ++n) _Pragma("unroll") for (int k = 0; k < 2; ++k) dst[n][k] = *(const PG8_LAS bf16x8*)(lds + PG8_SB(b, h) + boff + n * 2048 + k * 1024); } while (0)
#define PG8_MMA(ai, bj, At, Bt) do { __builtin_amdgcn_s_setprio(1); _Pragma("unroll") for (int m = 0; m < 4; ++m) _Pragma("unroll") for (int n = 0; n < 2; ++n) _Pragma("unroll") for (int k = 0; k < 2; ++k) \
        acc[ai][bj][m][n] = __builtin_amdgcn_mfma_f32_16x16x32_bf16(Bt[n][k], At[m][k], acc[ai][bj][m][n], 0, 0, 0); __builtin_amdgcn_s_setprio(0); } while (0)
#define PG8_WAIT_V(n) asm volatile("s_waitcnt vmcnt(" #n ")" ::: "memory")
#define PG8_WAIT_L(n) asm volatile("s_waitcnt lgkmcnt(" #n ")" ::: "memory")
#define PG8_BAR __builtin_amdgcn_s_barrier()
#define PG8_SCHED __builtin_amdgcn_sched_barrier(0)
    Unit cur, nxt; int ui = 0;
    if (!S.next(0, cur)) return;
    f32x4 acc[2][2][4][2];
#pragma unroll
    for (int a = 0; a < 2; ++a)
#pragma unroll
        for (int b = 0; b < 2; ++b)
#pragma unroll
            for (int m = 0; m < 4; ++m)
#pragma unroll
                for (int n = 0; n < 2; ++n) acc[a][b][m][n] = (f32x4){0.f, 0.f, 0.f, 0.f};
    bf16x8 At[4][2], B0[2][2], B1[2][2];
    const char* cA = (const char*)g.A + (size_t)cur.pm * tstep; const char* cB = (const char*)g.Bt + (size_t)cur.pn * tstep;
    S.a_ready(cur);
    if constexpr (SP2) {
        PG8_STAGE(PG8_SB(0, 0), cB, voffB); PG8_STAGE(PG8_SB(0, 1), cB + hstep, voffB); PG8_STAGE(PG8_SA(0, 0), cA, voffA); PG8_STAGE(PG8_SA(0, 1), cA + hstep, voffA);
        if (wr == 1) PG8_BAR;
        PG8_WAIT_V(2); PG8_BAR;
        PG8_STAGE(PG8_SB(1, 0), cB + kstep, voffB); PG8_STAGE(PG8_SA(1, 0), cA + kstep, voffA); PG8_STAGE(PG8_SB(1, 1), cB + hstep + kstep, voffB);
        PG8_WAIT_V(6); PG8_BAR;
    } else {
        PG8_STAGE(PG8_SB(0, 0), cB, voffB); PG8_STAGE(PG8_SA(0, 0), cA, voffA); PG8_STAGE(PG8_SB(0, 1), cB + hstep, voffB); PG8_STAGE(PG8_SA(0, 1), cA + hstep, voffA);
        if (wr == 1) PG8_BAR;
        PG8_WAIT_V(4); PG8_BAR;
        PG8_STAGE(PG8_SB(1, 0), cB + kstep, voffB); PG8_STAGE(PG8_SA(1, 0), cA + kstep, voffA); PG8_STAGE(PG8_SB(1, 1), cB + hstep + kstep, voffB);
        PG8_WAIT_V(6); PG8_BAR;
    }
    for (;;) {
        const bool has_next = S.next(ui + 1, nxt);
        const char* nA = has_next ? (const char*)g.A + (size_t)nxt.pm * tstep : cA; const char* nB = has_next ? (const char*)g.Bt + (size_t)nxt.pn * tstep : cB;
        for (int t = 0; t < nt; t += 2) {
            const bool last = (t == nt - 2);
            const char* a1 = cA + (size_t)(t + 1) * kstep;
            const char* a2 = last ? nA : cA + (size_t)(t + 2) * kstep; const char* b2 = last ? nB : cB + (size_t)(t + 2) * kstep;
            const char* a3 = a2 + kstep; const char* b3 = b2 + kstep;
            if (last && has_next) S.a_ready(nxt);
            if constexpr (SP2) {
            PG8_LDB(B0, 0, 0); PG8_LDB(B1, 0, 1); PG8_SCHED; PG8_LDA(At, 0, 0); PG8_STAGE(PG8_SA(1, 1), a1 + hstep, voffA);
            PG8_WAIT_V(8); PG8_WAIT_L(0); PG8_BAR; PG8_MMA(0, 0, At, B0); PG8_MMA(0, 1, At, B1); PG8_BAR; PG8_SCHED;
            PG8_LDA(At, 0, 1); PG8_STAGE(PG8_SB(0, 0), b2, voffB); PG8_STAGE(PG8_SB(0, 1), b2 + hstep, voffB); PG8_STAGE(PG8_SA(0, 0), a2, voffA);
            PG8_WAIT_V(8); PG8_WAIT_L(0); PG8_BAR; PG8_MMA(1, 0, At, B0); PG8_MMA(1, 1, At, B1); PG8_BAR; PG8_SCHED;
            PG8_LDB(B0, 1, 0); PG8_LDB(B1, 1, 1); PG8_SCHED; PG8_LDA(At, 1, 0); PG8_STAGE(PG8_SA(0, 1), a2 + hstep, voffA);
            PG8_WAIT_V(8); PG8_WAIT_L(0); PG8_BAR; PG8_MMA(0, 0, At, B0); PG8_MMA(0, 1, At, B1); PG8_BAR; PG8_SCHED;
            PG8_LDA(At, 1, 1); PG8_STAGE(PG8_SB(1, 0), b3, voffB); PG8_STAGE(PG8_SB(1, 1), b3 + hstep, voffB); PG8_STAGE(PG8_SA(1, 0), a3, voffA);
            PG8_WAIT_V(8); PG8_WAIT_L(0); PG8_BAR; PG8_MMA(1, 0, At, B0); PG8_MMA(1, 1, At, B1); PG8_BAR; PG8_SCHED;
            } else {
            PG8_LDB(B0, 0, 0); PG8_SCHED; PG8_LDA(At, 0, 0); PG8_STAGE(PG8_SA(1, 1), a1 + hstep, voffA);
            PG8_WAIT_L(8); PG8_BAR; PG8_WAIT_L(0); PG8_MMA(0, 0, At, B0); PG8_BAR; PG8_SCHED;
            PG8_LDB(B1, 0, 1); PG8_STAGE(PG8_SB(0, 0), b2, voffB);
            PG8_BAR; PG8_WAIT_L(0); PG8_MMA(0, 1, At, B1); PG8_BAR;
            PG8_LDA(At, 0, 1); PG8_STAGE(PG8_SA(0, 0), a2, voffA);
            PG8_BAR; PG8_WAIT_L(0); PG8_MMA(1, 0, At, B0); PG8_BAR; PG8_SCHED;
            PG8_STAGE(PG8_SB(0, 1), b2 + hstep, voffB);
            PG8_WAIT_V(6); PG8_BAR; PG8_MMA(1, 1, At, B1); PG8_BAR;
            PG8_LDB(B0, 1, 0); PG8_SCHED; PG8_LDA(At, 1, 0); PG8_STAGE(PG8_SA(0, 1), a2 + hstep, voffA);
            PG8_WAIT_L(8); PG8_BAR; PG8_WAIT_L(0); PG8_MMA(0, 0, At, B0); PG8_BAR; PG8_SCHED;
            PG8_LDB(B1, 1, 1); PG8_STAGE(PG8_SB(1, 0), b3, voffB);
            PG8_BAR; PG8_WAIT_L(0); PG8_MMA(0, 1, At, B1); PG8_BAR;
            PG8_LDA(At, 1, 1); PG8_STAGE(PG8_SA(1, 0), a3, voffA);
            PG8_BAR; PG8_WAIT_L(0); PG8_MMA(1, 0, At, B0); PG8_BAR; PG8_SCHED;
            PG8_STAGE(PG8_SB(1, 1), b3 + hstep, voffB);
            PG8_WAIT_V(6); PG8_BAR; PG8_MMA(1, 1, At, B1); PG8_BAR;
            }
        }
        if constexpr (ALIGN_EPI) { if (wr == 0) PG8_BAR; }
        if constexpr (!Epi::AFTER_DRAIN) { E(acc, cur, wr, wc, fr, fq); S.done(cur); }
        if (!has_next) break;
#pragma unroll
        for (int a = 0; a < 2; ++a)
#pragma unroll
            for (int b = 0; b < 2; ++b)
#pragma unroll
                for (int m = 0; m < 4; ++m)
#pragma unroll
                    for (int n = 0; n < 2; ++n) acc[a][b][m][n] = (f32x4){0.f, 0.f, 0.f, 0.f};
        cur = nxt; cA = nA; cB = nB; ++ui;
        if constexpr (ALIGN_EPI) { if (wr == 1) PG8_BAR; }
    }
    PG8_WAIT_V(0);
    if constexpr (!ALIGN_EPI) { if (wr == 0) PG8_BAR; }
    PG8_BAR;
    if constexpr (Epi::AFTER_DRAIN) { E.fused(acc, cur, wr, wc, fr, fq, lds, wid, lane); S.done(cur); }
#undef PG8_SA
#undef PG8_SB
#undef PG8_STAGE
#undef PG8_LDA
#undef PG8_LDB
#undef PG8_MMA
#undef PG8_WAIT_V
#undef PG8_WAIT_L
#undef PG8_BAR
#undef PG8_SCHED
}
}

namespace cg = cooperative_groups;
using pg8::bf16_t; using pg8::bf16x8; using pg8::f32x4; using pg8::u32x4;
#define LAS __attribute__((address_space(3)))
typedef unsigned u32x2 __attribute__((ext_vector_type(2)));
constexpr int D = 1024, MX = 32768, MALL = 33280, DFF = 2816, INC = 4608;
constexpr int NWAVES = 8, NTHREADS = 512, LDS_BYTES = 147456 + 256;
constexpr float EPS = 1e-6f, LOG2E = 1.4426950408889634f, QSCALE = 0.125f * 1.4426950408889634f;

constexpr size_t MiB = 1u << 20;
constexpr size_t CTL_MOD = 0;
constexpr size_t CTL_STATS = 221184;
constexpr size_t CTL_ROPE = 753664;
constexpr size_t CTL_CNT = 794624;
constexpr size_t CTL_BAR = 802816;
constexpr size_t CTL_XBAR = 819200;
constexpr size_t CTL_BYTES = 1 * MiB;
constexpr int LDS_BARST = 147456;
static_assert(CTL_STATS == 2 * 3 * 9216 * 4 && CTL_ROPE == CTL_STATS + 2 * 33280 * 2 * 4 && CTL_CNT == CTL_ROPE + 320 * 128 && CTL_CNT + 8 * 256 <= CTL_BYTES, "ctl map");
constexpr size_t WS_W = 1 * MiB, W_LAYER = 49 * MiB;
constexpr size_t W_UP1 = 0, W_DN1 = 11 * MiB, W_IN = W_DN1 + 5 * MiB + MiB / 2, W_PAB = W_IN + 9 * MiB, W_O = W_PAB + 4 * MiB, W_UP2 = W_O + 2 * MiB, W_DN2 = W_UP2 + 11 * MiB, W_S = W_DN2 + 5 * MiB + MiB / 2;
static_assert(W_S + 131072 <= W_LAYER, "weights map");
constexpr size_t WS_XC = WS_W + 2 * W_LAYER;
constexpr size_t WS_H = WS_XC + 2 * MiB;
constexpr size_t WS_MIX = WS_H + 65 * MiB;
constexpr size_t WS_QU = WS_MIX;
constexpr size_t WS_KB = WS_QU + 65 * MiB;
constexpr size_t WS_VT = WS_KB + 32 * MiB + MiB / 2;
constexpr size_t WS_VST = WS_VT + 32 * MiB + MiB / 2;
constexpr size_t WS_GT = WS_VST + 32 * MiB + MiB / 2;
constexpr size_t WS_END = WS_GT + 130 * MiB;
constexpr size_t WS_MRG = WS_KB;
constexpr size_t WS_G = WS_MIX;
static_assert((size_t)MALL * DFF * 2 <= WS_END - WS_MIX && WS_END <= 512 * MiB, "ws map");

struct Args { const float* in[22]; float* out; unsigned char* ws; };
typedef const __attribute__((address_space(4))) unsigned long long* kptr_t;
#define GAS __attribute__((address_space(1)))
#define KPTR(T, i) ((T*)(GAS T*)kp[(i)])

__device__ __forceinline__ float wave_sum(float v) {
#pragma unroll
    for (int o = 1; o < 64; o <<= 1) v += __shfl_xor(v, o);
    return v;
}
typedef float f32x2_t __attribute__((ext_vector_type(2))); typedef __bf16 bf16x2_t __attribute__((ext_vector_type(2)));
__device__ __forceinline__ unsigned cvtpk_s(float lo, float hi) { f32x2_t v = {lo, hi}; bf16x2_t b = __builtin_convertvector(v, bf16x2_t); return __builtin_bit_cast(unsigned, b); }
#define LDS_WAIT() asm volatile("s_waitcnt lgkmcnt(0)" ::: "memory")

__device__ __forceinline__ void transpose_item(const float* W, int N, bf16_t* WT, int ldw, int drow0, int dk0, LAS float* scr, int k0, int n0, int lane) {
#pragma unroll 8
    for (int i = 0; i < 32; ++i) { const int kk = 2 * i + (lane >> 5); scr[kk * 33 + (lane & 31)] = W[(size_t)(k0 + kk) * N + n0 + (lane & 31)]; }
    LDS_WAIT(); asm volatile("" ::: "memory");
    const int c = lane & 7;
#pragma unroll
    for (int j = 0; j < 4; ++j) { const int n = (lane >> 3) + 8 * j; const LAS float* s = scr + (8 * c) * 33 + n;
        u32x4 o; o.x = cvtpk_s(s[0 * 33], s[1 * 33]); o.y = cvtpk_s(s[2 * 33], s[3 * 33]); o.z = cvtpk_s(s[4 * 33], s[5 * 33]); o.w = cvtpk_s(s[6 * 33], s[7 * 33]);
        *(u32x4*)(WT + (size_t)(drow0 + n) * ldw + dk0 + k0 + 8 * c) = o; }
    LDS_WAIT(); asm volatile("" ::: "memory");
}
__device__ __forceinline__ int up_row(int n0) { return n0 < DFF ? 256 * (n0 / 128) + (n0 % 128) : 256 * ((n0 - DFF) / 128) + 128 + ((n0 - DFF) % 128); }

constexpr int IT_UP = 16 * 176, IT_DN = 44 * 32, IT_IN = 16 * 144, IT_P = 8 * 32, IT_O = 16 * 32, IT_Z = 2048, IT_S = 128;
constexpr int IT_LAYER = 2 * IT_UP + 2 * IT_DN + IT_IN + 2 * IT_P + IT_O + IT_Z + IT_S;
constexpr int IT_ADA = 2 * 36 * 16, IT_XC = 2048, IT_ROPE = 80;
constexpr int IT_TOTAL = IT_ADA + 2 * IT_LAYER + IT_XC + IT_ROPE;

__device__ __forceinline__ void prologue(const kptr_t kp, LAS float* scr, int gw, int NGW, int lane) {
    unsigned char* ws = KPTR(unsigned char, 23);
    for (int it = gw; it < IT_TOTAL; it += NGW) {
        int r = it;
        if (r < IT_ADA) {
            const int l = r / 576, rem = r % 576, cgp = rem / 16, ks = rem % 16, j0 = cgp * 256 + 4 * lane;
            const float* c = KPTR(const float, 1); const float* cc = KPTR(const float, 3);
            const float* wp = KPTR(const float, 4) + ((size_t)l * 1024 + ks * 64) * 9216 + j0;
            f32x4 a0 = {0.f, 0.f, 0.f, 0.f}, a1 = a0, a2 = a0;
#pragma unroll 4
            for (int kk = 0; kk < 64; ++kk) {
                const int k = ks * 64 + kk; const float x0 = c[k], x1 = c[1024 + k], x2 = cc[k];
                const float s0 = x0 / (1.0f + expf(-x0)), s1 = x1 / (1.0f + expf(-x1)), s2 = x2 / (1.0f + expf(-x2));
                const f32x4 w = *(const f32x4*)(wp + (size_t)kk * 9216);
                a0 += w * s0; a1 += w * s1; a2 += w * s2;
            }
            if (ks == 0) { const f32x4 b = *(const f32x4*)(KPTR(const float, 5) + l * 9216 + j0); a0 += b; a1 += b; a2 += b; }
            float* m = (float*)(ws + CTL_MOD) + (size_t)l * 3 * 9216 + j0;
#pragma unroll
            for (int e = 0; e < 4; ++e) { unsafeAtomicAdd(m + e, a0[e]); unsafeAtomicAdd(m + 9216 + e, a1[e]); unsafeAtomicAdd(m + 18432 + e, a2[e]); }
            continue;
        }
        r -= IT_ADA;
        if (r < 2 * IT_LAYER) {
            const int l = r / IT_LAYER; r -= l * IT_LAYER;
            unsigned char* wl = ws + WS_W + (size_t)l * W_LAYER;
            if (r < IT_UP) { const int kb = r / 176, nb = r % 176; transpose_item(KPTR(const float, 7) + (size_t)l * D * 2 * DFF, 2 * DFF, (bf16_t*)(wl + W_UP1), D, up_row(32 * nb), 0, scr, 64 * kb, 32 * nb, lane); continue; } r -= IT_UP;
            if (r < IT_DN) { const int kb = r / 32, nb = r % 32; transpose_item(KPTR(const float, 8) + (size_t)l * DFF * D, D, (bf16_t*)(wl + W_DN1), DFF, 32 * nb, 0, scr, 64 * kb, 32 * nb, lane); continue; } r -= IT_DN;
            if (r < IT_IN) { const int kb = r / 144, nb = r % 144; transpose_item(KPTR(const float, 9) + (size_t)l * D * INC, INC, (bf16_t*)(wl + W_IN), D, 32 * nb, 0, scr, 64 * kb, 32 * nb, lane); continue; } r -= IT_IN;
            if (r < IT_P) { const int kb = r / 32, nb = r % 32, n0 = 32 * nb; transpose_item(KPTR(const float, 16) + (size_t)l * 512 * D, D, (bf16_t*)(wl + W_PAB), D, 256 * (n0 / 128) + (n0 % 128), 0, scr, 64 * kb, n0, lane); continue; } r -= IT_P;
            if (r < IT_P) { const int kb = r / 32, nb = r % 32, n0 = 32 * nb; transpose_item(KPTR(const float, 17) + (size_t)l * 512 * D, D, (bf16_t*)(wl + W_PAB), D, 256 * (n0 / 128) + 128 + (n0 % 128), 512, scr, 64 * kb, n0, lane); continue; } r -= IT_P;
            if (r < IT_O) { const int kb = r / 32, nb = r % 32; transpose_item(KPTR(const float, 18) + (size_t)l * D * D, D, (bf16_t*)(wl + W_O), D, 32 * nb, 0, scr, 64 * kb, 32 * nb, lane); continue; } r -= IT_O;
            if (r < IT_UP) { const int kb = r / 176, nb = r % 176; transpose_item(KPTR(const float, 19) + (size_t)l * D * 2 * DFF, 2 * DFF, (bf16_t*)(wl + W_UP2), D, up_row(32 * nb), 0, scr, 64 * kb, 32 * nb, lane); continue; } r -= IT_UP;
            if (r < IT_DN) { const int kb = r / 32, nb = r % 32; transpose_item(KPTR(const float, 20) + (size_t)l * DFF * D, D, (bf16_t*)(wl + W_DN2), DFF, 32 * nb, 0, scr, 64 * kb, 32 * nb, lane); continue; } r -= IT_DN;
            if (r < IT_Z) {
                const int zk0 = ((r & 255) < 128) ? 512 : 0;
                *(u32x4*)((bf16_t*)(wl + W_PAB) + (size_t)r * D + zk0 + 8 * lane) = (u32x4){0u, 0u, 0u, 0u}; continue; } r -= IT_Z;
            {
                const float* s = KPTR(const float, 14) + (size_t)l * 65536 + (size_t)(r * 64 + lane) * 8; const f32x4 v0 = *(const f32x4*)s, v1 = *(const f32x4*)(s + 4);
                u32x4 o; o.x = cvtpk_s(v0[0], v0[1]); o.y = cvtpk_s(v0[2], v0[3]); o.z = cvtpk_s(v1[0], v1[1]); o.w = cvtpk_s(v1[2], v1[3]);
                *(u32x4*)((bf16_t*)(wl + W_S) + (size_t)(r * 64 + lane) * 8) = o; continue; }
        }
        r -= 2 * IT_LAYER;
        if (r < IT_XC) { const size_t idx = (size_t)(r * 64 + lane) * 4; *(f32x4*)((float*)(ws + WS_XC) + idx) = *(const f32x4*)(KPTR(const float, 2) + idx); continue; }
        r -= IT_XC;
        {
            const int id = r * 64 + lane, pos = id >> 4, j = id & 15; const int p = pos < 256 ? pos : pos - 256;
            const float freq = powf(10000.0f, -(float)j / 16.0f); const float ang = (float)p * freq;
            float* t = (float*)(ws + CTL_ROPE) + (size_t)id * 2; t[0] = cosf(ang); t[1] = sinf(ang);
        }
    }
}

__device__ __forceinline__ void modpass(const float* xs_main, const float* xs_ctx, const float* mod_l, const float* g, int i, bf16_t* H, int nrows, int gw, int NGW, int lane) {
    for (int row = gw; row < nrows; row += NGW) {
        const float* xr = row < MX ? xs_main + (size_t)row * D : xs_ctx + (size_t)(row - MX) * D;
        const int cond = row < 16384 ? 0 : (row < MX ? 1 : 2);
        const float* shift = mod_l + cond * 9216 + 3 * i * 1024; const float* scale = shift + 1024;
        f32x4 v[4]; float ss = 0.f;
#pragma unroll
        for (int j = 0; j < 4; ++j) { v[j] = *(const f32x4*)(xr + 4 * lane + 256 * j); ss += (v[j][0] * v[j][0] + v[j][1] * v[j][1]) + (v[j][2] * v[j][2] + v[j][3] * v[j][3]); }
        const float rstd = 1.0f / sqrtf(wave_sum(ss) * (1.0f / D) + EPS);
#pragma unroll
        for (int j = 0; j < 4; ++j) {
            const int c = 4 * lane + 256 * j; const f32x4 gg = *(const f32x4*)(g + c), sc = *(const f32x4*)(scale + c), sh = *(const f32x4*)(shift + c);
            const f32x4 o = v[j] * rstd * gg * (sc + 1.0f) + sh;
            u32x2 w; w.x = cvtpk_s(o[0], o[1]); w.y = cvtpk_s(o[2], o[3]);
            *(u32x2*)(H + (size_t)row * D + c) = w;
        }
    }
}
__device__ __forceinline__ void final_norm(float* out, const float* g, int gw, int NGW, int lane) {
    for (int row = gw; row < MX; row += NGW) {
        float* xr = out + (size_t)row * D; f32x4 v[4]; float ss = 0.f;
#pragma unroll
        for (int j = 0; j < 4; ++j) { v[j] = *(const f32x4*)(xr + 4 * lane + 256 * j); ss += (v[j][0] * v[j][0] + v[j][1] * v[j][1]) + (v[j][2] * v[j][2] + v[j][3] * v[j][3]); }
        const float rstd = 1.0f / sqrtf(wave_sum(ss) * (1.0f / D) + EPS);
#pragma unroll
        for (int j = 0; j < 4; ++j) { const int c = 4 * lane + 256 * j; *(f32x4*)(xr + c) = v[j] * rstd * *(const f32x4*)(g + c); }
    }
}

#define MFMA16(a, b, c) __builtin_amdgcn_mfma_f32_16x16x32_bf16((a), (b), (c), 0, 0, 0)
__device__ __forceinline__ int wq_next(unsigned* cnt, int lane) { unsigned v = 0u; if (lane == 0) v = atomicAdd(cnt, 1u); return (int)__builtin_amdgcn_readfirstlane(v); }

__device__ __forceinline__ void attn_unit(int u, const bf16_t* KB, const bf16_t* VT, const bf16_t* QU, bf16_t* OB, const LAS float* rpb_l, LAS unsigned char* ot, int lane_) {
    int lane = lane_; asm volatile("" : "+v"(lane));
    const int fr = lane & 15, fq = lane >> 4;
    const bool isx = u < 16384;
    int b, h, cb, r = 0, qrow0, rs = 0, c0 = 0;
    if (isx) { cb = u & 3; h = (u >> 2) & 7; r = (u >> 5) & 255; b = u >> 13; qrow0 = b * 16384 + r * 64 + 16 * cb; rs = min(max(r - 4, 0), 248); c0 = (cb == 0) ? 0 : (cb == 1 ? 8 : (cb == 2 ? 24 : 32)); }
    else { const int uu = u - 16384; cb = uu & 3; h = (uu >> 2) & 7; const int rg = (uu >> 5) & 3; b = uu >> 7; qrow0 = MX + b * 256 + rg * 64 + 16 * cb; }
    bf16x8 bq0, bq1; { const bf16_t* qp = QU + (size_t)(qrow0 + fr) * 1024 + h * 64 + 8 * fq; bq0 = *(const bf16x8*)qp; bq1 = *(const bf16x8*)(qp + 32); }
    const int kk0 = 8 * (fr >> 2) + (fr & 3);
    const f32x4 z4 = {0.f, 0.f, 0.f, 0.f};
    const float NEG = -INFINITY;
    f32x4 st[8][2];
    f32x4 o[4] = {z4, z4, z4, z4};
    float m = NEG, l = 0.f;
    bf16x8 fb[32];
#define ATTN_SB() __builtin_amdgcn_sched_barrier(0)
    if (isx) {
        const bf16_t* kp0 = KB + ((size_t)h * MALL + (b * 16384 + rs * 64 + c0 + kk0)) * 64 + 8 * fq;
#pragma unroll
        for (int i = 0; i < 8; ++i)
#pragma unroll
            for (int t = 0; t < 2; ++t) { const bf16_t* kp = kp0 + (size_t)(i * 64 + 4 * t) * 64; fb[i * 4 + t * 2] = *(const bf16x8*)kp; fb[i * 4 + t * 2 + 1] = *(const bf16x8*)(kp + 32); }
        ATTN_SB();
#pragma unroll
        for (int i = 0; i < 8; ++i)
#pragma unroll
            for (int t = 0; t < 2; ++t) { f32x4 s = MFMA16(fb[i * 4 + t * 2], bq0, z4); s = MFMA16(fb[i * 4 + t * 2 + 1], bq1, s); st[i][t] = s; }
        ATTN_SB();
        const bf16_t* vp0 = VT + ((size_t)(((b * 16384 + rs * 64 + c0) >> 3) + fq) * 512 + h * 64 + fr) * 8;
#pragma unroll
        for (int i = 0; i < 8; ++i)
#pragma unroll
            for (int dt = 0; dt < 4; ++dt) fb[i * 4 + dt] = *(const bf16x8*)(vp0 + (size_t)(i * 8 * 512 + dt * 16) * 8);
        ATTN_SB();
        const int c = 16 * cb + fr, cs = min(max(c - 8, 0), 48); const LAS float* rp = rpb_l + h * 465 + (rs - r + 7) * 31;
#pragma unroll
        for (int t = 0; t < 2; ++t)
#pragma unroll
            for (int e = 0; e < 4; ++e) { const int kc = c0 + 8 * fq + 4 * t + e; const bool valid = (kc >= cs) && (kc < cs + 16); const int dc = min(max(kc - c + 15, 0), 30);
                float bz[8];
#pragma unroll
                for (int i = 0; i < 8; ++i) bz[i] = rp[i * 31 + dc];
                asm volatile("" : "+v"(bz[0]), "+v"(bz[1]), "+v"(bz[2]), "+v"(bz[3]), "+v"(bz[4]), "+v"(bz[5]), "+v"(bz[6]), "+v"(bz[7]));
#pragma unroll
                for (int i = 0; i < 8; ++i) st[i][t][e] = valid ? st[i][t][e] + bz[i] : NEG; }
#pragma unroll
        for (int g = 0; g < 8; ++g)
#pragma unroll
            for (int t = 0; t < 2; ++t) m = fmaxf(m, fmaxf(fmaxf(st[g][t][0], st[g][t][1]), fmaxf(st[g][t][2], st[g][t][3])));
        m = fmaxf(m, __shfl_xor(m, 16)); m = fmaxf(m, __shfl_xor(m, 32));
#pragma unroll
        for (int g = 0; g < 8; ++g)
#pragma unroll
            for (int t = 0; t < 2; ++t)
#pragma unroll
                for (int e = 0; e < 4; ++e) { const float p = __builtin_amdgcn_exp2f(st[g][t][e] - m); st[g][t][e] = p; l += p; }
        ATTN_SB();
#pragma unroll
        for (int i = 0; i < 8; ++i) {
            u32x4 pw; pw.x = cvtpk_s(st[i][0][0], st[i][0][1]); pw.y = cvtpk_s(st[i][0][2], st[i][0][3]); pw.z = cvtpk_s(st[i][1][0], st[i][1][1]); pw.w = cvtpk_s(st[i][1][2], st[i][1][3]);
            const bf16x8 pa = __builtin_bit_cast(bf16x8, pw);
#pragma unroll
            for (int dt = 0; dt < 4; ++dt) o[dt] = MFMA16(pa, fb[i * 4 + dt], o[dt]);
        }
        ATTN_SB();
    }
    {
        const bf16_t* kp0 = KB + ((size_t)h * MALL + (MX + b * 256 + kk0)) * 64 + 8 * fq;
#pragma unroll
        for (int j = 0; j < 8; ++j)
#pragma unroll
            for (int t = 0; t < 2; ++t) { const bf16_t* kp = kp0 + (size_t)(32 * j + 4 * t) * 64; fb[j * 4 + t * 2] = *(const bf16x8*)kp; fb[j * 4 + t * 2 + 1] = *(const bf16x8*)(kp + 32); }
        ATTN_SB();
#pragma unroll
        for (int j = 0; j < 8; ++j)
#pragma unroll
            for (int t = 0; t < 2; ++t) { f32x4 s = MFMA16(fb[j * 4 + t * 2], bq0, z4); s = MFMA16(fb[j * 4 + t * 2 + 1], bq1, s); st[j][t] = s; }
        ATTN_SB();
        const bf16_t* vp0 = VT + ((size_t)(((MX + b * 256) >> 3) + fq) * 512 + h * 64 + fr) * 8;
#pragma unroll
        for (int j = 0; j < 8; ++j)
#pragma unroll
            for (int dt = 0; dt < 4; ++dt) fb[j * 4 + dt] = *(const bf16x8*)(vp0 + (size_t)(j * 4 * 512 + dt * 16) * 8);
        ATTN_SB();
        float m2 = NEG;
#pragma unroll
        for (int g = 0; g < 8; ++g)
#pragma unroll
            for (int t = 0; t < 2; ++t) m2 = fmaxf(m2, fmaxf(fmaxf(st[g][t][0], st[g][t][1]), fmaxf(st[g][t][2], st[g][t][3])));
        m2 = fmaxf(m2, __shfl_xor(m2, 16)); m2 = fmaxf(m2, __shfl_xor(m2, 32));
        const float mn = fmaxf(m, m2);
        const float alpha = __builtin_amdgcn_exp2f(m - mn);
        l *= alpha;
#pragma unroll
        for (int e = 0; e < 4; ++e) { const float aq = __shfl(alpha, 4 * fq + e);
#pragma unroll
            for (int dt = 0; dt < 4; ++dt) o[dt][e] *= aq; }
#pragma unroll
        for (int g = 0; g < 8; ++g)
#pragma unroll
            for (int t = 0; t < 2; ++t)
#pragma unroll
                for (int e = 0; e < 4; ++e) { const float p = __builtin_amdgcn_exp2f(st[g][t][e] - mn); st[g][t][e] = p; l += p; }
        ATTN_SB();
#pragma unroll
        for (int j = 0; j < 8; ++j) {
            u32x4 pw; pw.x = cvtpk_s(st[j][0][0], st[j][0][1]); pw.y = cvtpk_s(st[j][0][2], st[j][0][3]); pw.z = cvtpk_s(st[j][1][0], st[j][1][1]); pw.w = cvtpk_s(st[j][1][2], st[j][1][3]);
            const bf16x8 pa = __builtin_bit_cast(bf16x8, pw);
#pragma unroll
            for (int dt = 0; dt < 4; ++dt) o[dt] = MFMA16(pa, fb[j * 4 + dt], o[dt]);
        }
    }
    __builtin_amdgcn_sched_barrier(0);
    l += __shfl_xor(l, 16); l += __shfl_xor(l, 32);
    const float inv = 1.0f / l;
    asm volatile("" ::: "memory");
#pragma unroll
    for (int e = 0; e < 4; ++e) { const float il = __shfl(inv, 4 * fq + e);
#pragma unroll
        for (int dt = 0; dt < 4; ++dt) *(LAS unsigned short*)(ot + (4 * fq + e) * 128 + (dt * 16 + fr) * 2) = pg8::f2bf_rne(o[dt][e] * il); }
    asm volatile("" ::: "memory");
#pragma unroll
    for (int k = 0; k < 2; ++k) { const int p = lane + 64 * k, q = p >> 3, dc = p & 7;
        const u32x4 w = *(const LAS u32x4*)(ot + q * 128 + dc * 16);
        *(u32x4*)(OB + (size_t)(qrow0 + q) * 1024 + h * 64 + dc * 8) = w; }
    asm volatile("" ::: "memory");
}

template <int NMT> __device__ __forceinline__ void sg_unit(int chunk, int g, int cofs, const bf16_t* VST, const bf16_t* QU, bf16_t* OB, const float* stats, const float* lng, const float* lnb, const bf16_t* WSb, const float* bs, int lane_) {
    int lane = lane_; asm volatile("" : "+v"(lane));
    const int fr = lane & 15, fq = lane >> 4;
    const int R0 = chunk < 256 ? chunk * 128 : MX + (chunk - 256) * 128;
    const int ch0 = g * 128 + cofs;
    u32x4 raw[NMT][4]; pg8::f32x2 sv[4][8];
#pragma unroll
    for (int ks = 0; ks < 4; ++ks) {
#pragma unroll
        for (int j = 0; j < 8; ++j) sv[ks][j] = *(const pg8::f32x2*)(stats + 2 * (size_t)(R0 + ks * 32 + 8 * fq + j));
#pragma unroll
        for (int mt = 0; mt < NMT; ++mt) raw[mt][ks] = *(const u32x4*)(VST + ((size_t)((R0 >> 3) + ks * 4 + fq) * 512 + ch0 + mt * 16 + fr) * 8);
    }
    float lg[NMT], lb[NMT];
#pragma unroll
    for (int mt = 0; mt < NMT; ++mt) { lg[mt] = lng[ch0 + mt * 16 + fr]; lb[mt] = lnb[ch0 + mt * 16 + fr]; }
    const bf16_t* wp0 = WSb + (size_t)(g * 128 + fr) * 128 + 8 * fq;
    bf16x8 wf[2][4]; u32x2 uu[2][NMT]; float bsv[2];
#pragma unroll
    for (int ks = 0; ks < 4; ++ks) wf[0][ks] = *(const bf16x8*)(wp0 + ks * 32);
#pragma unroll
    for (int mt = 0; mt < NMT; ++mt) uu[0][mt] = *(const u32x2*)(QU + (size_t)(R0 + fr) * 1024 + 512 + ch0 + mt * 16 + 4 * fq);
    bsv[0] = bs[g * 128 + fr];
    __builtin_amdgcn_sched_barrier(0);
    bf16x8 af[NMT][4];
#pragma unroll
    for (int ks = 0; ks < 4; ++ks) {
        float mu[8], rs[8];
#pragma unroll
        for (int j = 0; j < 8; ++j) { const float mean = sv[ks][j][0] * (1.0f / 512.0f); const float var = fmaxf(sv[ks][j][1] * (1.0f / 512.0f) - mean * mean, 0.f); mu[j] = mean; rs[j] = 1.0f / sqrtf(var + EPS); }
#pragma unroll
        for (int mt = 0; mt < NMT; ++mt) {
            const u32x4 rw = raw[mt][ks];
            float v[8]; v[0] = pg8::bflo(rw.x); v[1] = pg8::bfhi(rw.x); v[2] = pg8::bflo(rw.y); v[3] = pg8::bfhi(rw.y); v[4] = pg8::bflo(rw.z); v[5] = pg8::bfhi(rw.z); v[6] = pg8::bflo(rw.w); v[7] = pg8::bfhi(rw.w);
#pragma unroll
            for (int j = 0; j < 8; ++j) v[j] = (v[j] - mu[j]) * rs[j] * lg[mt] + lb[mt];
            u32x4 pw; pw.x = cvtpk_s(v[0], v[1]); pw.y = cvtpk_s(v[2], v[3]); pw.z = cvtpk_s(v[4], v[5]); pw.w = cvtpk_s(v[6], v[7]);
            af[mt][ks] = __builtin_bit_cast(bf16x8, pw);
        }
    }
    const f32x4 z4 = {0.f, 0.f, 0.f, 0.f};
#pragma unroll
    for (int nt = 0; nt < 8; ++nt) {
        const int cur = nt & 1, nxt = cur ^ 1;
        if (nt < 7) {
#pragma unroll
            for (int ks = 0; ks < 4; ++ks) wf[nxt][ks] = *(const bf16x8*)(wp0 + (size_t)(nt + 1) * 16 * 128 + ks * 32);
#pragma unroll
            for (int mt = 0; mt < NMT; ++mt) uu[nxt][mt] = *(const u32x2*)(QU + (size_t)(R0 + (nt + 1) * 16 + fr) * 1024 + 512 + ch0 + mt * 16 + 4 * fq);
            bsv[nxt] = bs[g * 128 + (nt + 1) * 16 + fr];
        }
        f32x4 a[NMT];
#pragma unroll
        for (int mt = 0; mt < NMT; ++mt) a[mt] = z4;
#pragma unroll
        for (int ks = 0; ks < 4; ++ks)
#pragma unroll
            for (int mt = 0; mt < NMT; ++mt) a[mt] = MFMA16(af[mt][ks], wf[cur][ks], a[mt]);
        const float bv = bsv[cur];
        unsigned q[NMT][2];
#pragma unroll
        for (int mt = 0; mt < NMT; ++mt) { const u32x2 u0 = uu[cur][mt];
            q[mt][0] = cvtpk_s(pg8::bflo(u0.x) * (a[mt][0] + bv), pg8::bfhi(u0.x) * (a[mt][1] + bv)); q[mt][1] = cvtpk_s(pg8::bflo(u0.y) * (a[mt][2] + bv), pg8::bfhi(u0.y) * (a[mt][3] + bv)); }
        const size_t uo = (size_t)(R0 + nt * 16 + fr) * 1024 + 512 + ch0;
#pragma unroll
        for (int mp = 0; mp < NMT / 2; ++mp) { int co; const u32x4 w = pg8::quad_swap(q[2 * mp][0], q[2 * mp][1], q[2 * mp + 1][0], q[2 * mp + 1][1], fq, co); *(u32x4*)(OB + uo + mp * 32 + co) = w; }
    }
}

__device__ __forceinline__ void ctx_resid_gemm(const bf16_t* A  , const bf16_t* Bt  , int K, float* XC, const float* gate  , float coef, int gw, int NGW, int lane) {
    const int fr = lane & 15, fq = lane >> 4;
    for (int tile = gw; tile < 32 * 64; tile += NGW) {
        const int rt = tile >> 6, ct = tile & 63;
        const bf16_t* ap = A + (size_t)(MX + rt * 16 + fr) * K + 8 * fq; const bf16_t* bp = Bt + (size_t)(ct * 16 + fr) * K + 8 * fq;
        f32x4 acc0 = {0.f, 0.f, 0.f, 0.f}, acc1 = acc0;
#pragma unroll 4
        for (int ks = 0; ks < K; ks += 64) {
            acc0 = MFMA16(*(const bf16x8*)(ap + ks), *(const bf16x8*)(bp + ks), acc0);
            acc1 = MFMA16(*(const bf16x8*)(ap + ks + 32), *(const bf16x8*)(bp + ks + 32), acc1);
        }
        const int col = ct * 16 + fr; const float gv = gate[col] * coef;
#pragma unroll
        for (int e = 0; e < 4; ++e) { float* xp = XC + (size_t)(rt * 16 + 4 * fq + e) * D + col; *xp = *xp + gv * (acc0[e] + acc1[e]); }
    }
}

#ifndef MK_SP2
#define MK_SP2 true
#endif
#ifndef MK_ALIGN
#define MK_ALIGN true
#endif
template <class Epi> __device__ __forceinline__ void run_gemm(LAS unsigned char* lds, const bf16_t* A, const bf16_t* Bt, int M, int N, int K, const Epi& E) {
    pg8::Gemm g{A, Bt, M, N, K}; pg8::StaticOrder S; S.init(M, N, (int)gridDim.x, (int)blockIdx.x);
    pg8::gemm_phase<Epi, pg8::StaticOrder, MK_ALIGN, MK_SP2>(lds, g, S, E);
}


__device__ __forceinline__ kptr_t kargs() { kptr_t p = (kptr_t)__builtin_amdgcn_kernarg_segment_ptr(); asm volatile("" : "+s"(p)); return p; }
#define KIN(i) KPTR(const float, i)
#define KOUT() KPTR(float, 22)
#define KWS() KPTR(unsigned char, 23)
#define PH_BEGIN() const kptr_t kp = kargs(); unsigned char* const ws = KWS(); (void)ws; int tid_ = threadIdx.x; asm volatile("" : "+v"(tid_)); const int lane = tid_ & 63, wave = __builtin_amdgcn_readfirstlane(tid_ >> 6); \
    const int gw = blockIdx.x * NWAVES + wave, NGW = gridDim.x * NWAVES; (void)lane; (void)gw; (void)NGW

#define RLX_AGENT __ATOMIC_RELAXED, __HIP_MEMORY_SCOPE_AGENT
#define XB_TMO      128
#define XB_XCNT(j)  (256  + 64 * (j))
#define XB_XSUB(j)  (1280 + 64 * (j))
#define XB_XGEN(j)  (2304 + 64 * (j))
#define XB_TOP      3328
#define XB_TOPGEN   3392
#define XCD_BAR_WORDS 3456
#define XB_SPIN_CAP (1u << 18)

__device__ __forceinline__ unsigned xb_ld(unsigned* p)              { return __hip_atomic_load(p, __ATOMIC_RELAXED, __HIP_MEMORY_SCOPE_AGENT); }
__device__ __forceinline__ unsigned xb_add(unsigned* p, unsigned v) { return __hip_atomic_fetch_add(p, v, __ATOMIC_RELAXED, __HIP_MEMORY_SCOPE_AGENT); }
__device__ __forceinline__ unsigned xb_xcc_id() { return (unsigned)__builtin_amdgcn_s_getreg((3 << 11) | 20) & 0xFu; }
#define XB_SPIN(cond, bar) do { unsigned _sp = 0; while (cond) { __builtin_amdgcn_s_sleep(1); \
    if ((++_sp & 255u) == 0u) { if (xb_ld(&(bar)[XB_TMO])) break; if (_sp > XB_SPIN_CAP) { atomicAdd(&(bar)[XB_TMO], 1u); break; } } } } while (0)

struct XcdBarrier {
    unsigned* bar; unsigned x;
    volatile LAS unsigned* st;
};

__device__ __forceinline__ XcdBarrier xcd_barrier_post(unsigned* bar, volatile LAS unsigned* st) {
    XcdBarrier b; b.bar = bar; b.x = xb_xcc_id(); b.st = st;
    if (threadIdx.x == 0) (void)xb_add(&bar[XB_XCNT(b.x)], 1u);
    return b;
}
__device__ __forceinline__ void xcd_barrier_complete(unsigned* bar, unsigned x, unsigned& nloc, unsigned& nx) {
    const unsigned G = gridDim.x * gridDim.y * gridDim.z;
    unsigned sum, cnt, mine, sp = 0u;
    for (;;) {
        sum = 0u; cnt = 0u; mine = 0u;
#pragma unroll
        for (unsigned j = 0; j < 16; ++j) { const unsigned c = xb_ld(&bar[XB_XCNT(j)]); sum += c; cnt += (c > 0u) ? 1u : 0u; mine = (j == x) ? c : mine; }
        if (sum == G) break;
        __builtin_amdgcn_s_sleep(1);
        if ((++sp & 255u) == 0u) { if (xb_ld(&bar[XB_TMO])) break; if (sp > XB_SPIN_CAP) { atomicAdd(&bar[XB_TMO], 1u); break; } }
    }
    nloc = mine > 0u ? mine : 1u; nx = cnt > 0u ? cnt : 1u;
}

__device__ __forceinline__ void xcd_barrier(const XcdBarrier& b) {
    asm volatile("s_waitcnt vmcnt(0)" ::: "memory");
    __syncthreads();
    if (threadIdx.x == 0) {
        unsigned* bar = b.bar;
        __builtin_amdgcn_s_waitcnt(0);
        unsigned nloc = b.st[0], nx = b.st[1];
        if (nloc == 0u) { xcd_barrier_complete(bar, b.x, nloc, nx); b.st[0] = nloc; b.st[1] = nx; }
        const unsigned old = xb_add(&bar[XB_XSUB(b.x)], 1u);
        const unsigned gen = old / nloc;
        if (old + 1u == (gen + 1u) * nloc) {
            __builtin_amdgcn_fence(__ATOMIC_RELEASE, "agent");
            asm volatile("s_waitcnt vmcnt(0)" ::: "memory");
            const unsigned og = xb_add(&bar[XB_TOP], 1u);
            const unsigned tg = og / nx;
            if (og + 1u == (tg + 1u) * nx) xb_add(&bar[XB_TOPGEN], 1u);
            else XB_SPIN(xb_ld(&bar[XB_TOPGEN]) == tg, bar);
            __builtin_amdgcn_fence(__ATOMIC_ACQUIRE, "agent");
            xb_add(&bar[XB_XGEN(b.x)], 1u);
            asm volatile("s_waitcnt vmcnt(0)" ::: "memory");
        } else {
            XB_SPIN(xb_ld(&bar[XB_XGEN(b.x)]) == gen, bar);
            __builtin_amdgcn_fence(__ATOMIC_ACQUIRE, "agent");
            asm volatile("s_waitcnt vmcnt(0)" ::: "memory");
        }
    }
    __syncthreads();
}


__device__ __forceinline__ void gbar(int k, int word = 0) {
    asm volatile("s_waitcnt vmcnt(0)" ::: "memory");
    __syncthreads();
    if (threadIdx.x == 0) {
        const kptr_t kp = kargs(); unsigned* cnt = (unsigned*)(KPTR(unsigned char, 23) + CTL_BAR) + word;
        __builtin_amdgcn_fence(__ATOMIC_RELEASE, "agent");
        asm volatile("s_waitcnt vmcnt(0)" ::: "memory");
        (void)__hip_atomic_fetch_add(cnt, 1u, __ATOMIC_RELAXED, __HIP_MEMORY_SCOPE_AGENT);
        const unsigned target = (unsigned)(k + 1) * gridDim.x;
        unsigned sp = 0u;
        while (__hip_atomic_load(cnt, __ATOMIC_RELAXED, __HIP_MEMORY_SCOPE_AGENT) < target) { __builtin_amdgcn_s_sleep(1); if (++sp > (1u << 24)) break; }
        __builtin_amdgcn_fence(__ATOMIC_ACQUIRE, "agent");
        asm volatile("s_waitcnt vmcnt(0)" ::: "memory");
    }
    __syncthreads();
}
#ifdef PROBE_SYNC
#define GSYNC(j) do { gbar(2 * (L * 11 + (j))); gbar(2 * (L * 11 + (j)) + 1); } while (0)
#else
__device__ __forceinline__ void xbar(LAS unsigned char* lds) {
    const kptr_t kp = kargs(); XcdBarrier b; b.bar = (unsigned*)(KPTR(unsigned char, 23) + CTL_XBAR); b.x = xb_xcc_id(); b.st = (volatile LAS unsigned*)(lds + LDS_BARST);
    xcd_barrier(b);
}
#define GSYNC(j) xbar(lds)
#endif
template <int L> __device__ __forceinline__ void layer_fwd(cg::grid_group& grid, LAS unsigned char* lds) {
    constexpr int Mr = (L == 0) ? MALL : MX;
    constexpr size_t WL = WS_W + (size_t)L * W_LAYER, MODL = CTL_MOD + (size_t)L * 3 * 9216 * 4, STL = CTL_STATS + (size_t)L * MALL * 2 * 4;
    { PH_BEGIN(); modpass(L == 0 ? KIN(0) : KOUT(), (const float*)(ws + WS_XC), (const float*)(ws + MODL), KIN(6) + (size_t)(L * 3 + 0) * D, 0, (bf16_t*)(ws + WS_H), MALL, gw, NGW, lane); }
    GSYNC(0);
    { PH_BEGIN(); run_gemm(lds, (const bf16_t*)(ws + WS_H), (const bf16_t*)(ws + WL + W_UP1), MALL, 2 * DFF, D, pg8::EpiSwiGLU{(bf16_t*)(ws + WS_G)}); }
    GSYNC(1);
    { PH_BEGIN(); run_gemm(lds, (const bf16_t*)(ws + WS_G), (const bf16_t*)(ws + WL + W_DN1), MX, D, DFF,
                           pg8::EpiResid{L == 0 ? KIN(0) : KOUT(), (const float*)(ws + WS_XC), KOUT(), (float*)(ws + WS_XC), (const float*)(ws + MODL) + 2 * 1024, 0.5f}); }
    { PH_BEGIN(); ctx_resid_gemm((const bf16_t*)(ws + WS_G), (const bf16_t*)(ws + WL + W_DN1), DFF, (float*)(ws + WS_XC), (const float*)(ws + MODL) + 2 * 9216 + 2 * 1024, 0.5f, gw, NGW, lane); }
    GSYNC(2);
    { PH_BEGIN(); modpass(KOUT(), (const float*)(ws + WS_XC), (const float*)(ws + MODL), KIN(6) + (size_t)(L * 3 + 1) * D, 1, (bf16_t*)(ws + WS_H), MALL, gw, NGW, lane); }
    GSYNC(3);
    { PH_BEGIN(); run_gemm(lds, (const bf16_t*)(ws + WS_H), (const bf16_t*)(ws + WL + W_IN), MALL, INC, D,
                           pg8::EpiWin{(bf16_t*)(ws + WS_QU), (bf16_t*)(ws + WS_KB), (bf16_t*)(ws + WS_VT), (bf16_t*)(ws + WS_VST), (bf16_t*)(ws + WS_GT), KIN(10) + (size_t)L * 2048,
                                       (const f32x4*)(ws + CTL_ROPE), (const f32x4*)(ws + CTL_ROPE) + 256 * 8, (float*)(ws + STL), QSCALE, lds + 131072}); }
    GSYNC(4);
#ifdef PROBE_ATTN
    constexpr int NREP_ATTN = 2;
#else
    constexpr int NREP_ATTN = 1;
#endif
#pragma unroll 1
    for (int rep = 0; rep < NREP_ATTN; ++rep) { PH_BEGIN();
        if (rep > 0) gbar(L, 64);
        unsigned* cnt_attn = (unsigned*)(ws + CTL_CNT) + 64 * (2 * L) + 256 * rep;
        constexpr int nat = (L == 0) ? 16384 + 256 : 16384;
        { const float* rg = KIN(11) + (size_t)L * 8 * 465; for (int i = threadIdx.x; i < 8 * 465; i += NTHREADS) ((LAS float*)lds)[i] = rg[i] * LOG2E; }
        __syncthreads();
        const bool stat = gridDim.x == 256; const int lw = (blockIdx.x >> 3) * 8 + wave, qbase = stat ? 16384 : 0;
#pragma unroll 1
        for (int it = 0; ; ++it) {
            int u;
            if (stat && it < 8) { const int pair = it * 8 + (lw >> 5), bb = pair >> 5, rr = 32 * (blockIdx.x & 7) + (pair & 31); u = (bb << 13) | (rr << 5) | (lw & 31); }
            else { u = qbase + wq_next(cnt_attn, lane); if (u >= nat) break; }
            attn_unit(u, (const bf16_t*)(ws + WS_KB), (const bf16_t*)(ws + WS_VT), (const bf16_t*)(ws + WS_QU), (bf16_t*)(ws + WS_H), (const LAS float*)lds, lds + 16384 + wave * 2048, lane);
        }
    }
    { PH_BEGIN();
        unsigned* cnt_sg = (unsigned*)(ws + CTL_CNT) + 64 * (2 * L + 1);
        const bf16_t* VSTp = (const bf16_t*)(ws + WS_VST); const bf16_t* QUp = (const bf16_t*)(ws + WS_QU); bf16_t* OBp = (bf16_t*)(ws + WS_H); const float* stp = (const float*)(ws + STL); const bf16_t* wsb = (const bf16_t*)(ws + WL + W_S);
        for (int u = gw; u < 2048; u += NGW) sg_unit<4>(u >> 3, (u >> 1) & 3, (u & 1) * 64, VSTp, QUp, OBp, stp, KIN(12) + L * 512, KIN(13) + L * 512, wsb, KIN(15) + L * 512, lane);
        if (L == 0)
            for (;;) { const int u = wq_next(cnt_sg, lane); if (u >= 64) break; sg_unit<2>(256 + (u >> 4), (u >> 2) & 3, (u & 3) * 32, VSTp, QUp, OBp, stp, KIN(12) + L * 512, KIN(13) + L * 512, wsb, KIN(15) + L * 512, lane); }
    }
    GSYNC(5);
    { PH_BEGIN(); run_gemm(lds, (const bf16_t*)(ws + WS_H), (const bf16_t*)(ws + WL + W_PAB), Mr, 2048, D, pg8::EpiMerge{(const bf16_t*)(ws + WS_GT), (bf16_t*)(ws + WS_MRG)}); }
    GSYNC(6);
    { PH_BEGIN(); run_gemm(lds, (const bf16_t*)(ws + WS_MRG), (const bf16_t*)(ws + WL + W_O), MX, D, D,
                           pg8::EpiResid{KOUT(), (const float*)(ws + WS_XC), KOUT(), (float*)(ws + WS_XC), (const float*)(ws + MODL) + 5 * 1024, 1.0f}); }
    if (L == 0) { PH_BEGIN(); ctx_resid_gemm((const bf16_t*)(ws + WS_MRG), (const bf16_t*)(ws + WL + W_O), D, (float*)(ws + WS_XC), (const float*)(ws + MODL) + 2 * 9216 + 5 * 1024, 1.0f, gw, NGW, lane); }
    GSYNC(7);
    { PH_BEGIN(); modpass(KOUT(), (const float*)(ws + WS_XC), (const float*)(ws + MODL), KIN(6) + (size_t)(L * 3 + 2) * D, 2, (bf16_t*)(ws + WS_H), Mr, gw, NGW, lane); }
    GSYNC(8);
    { PH_BEGIN(); run_gemm(lds, (const bf16_t*)(ws + WS_H), (const bf16_t*)(ws + WL + W_UP2), Mr, 2 * DFF, D, pg8::EpiSwiGLU{(bf16_t*)(ws + WS_G)}); }
    GSYNC(9);
    { PH_BEGIN(); run_gemm(lds, (const bf16_t*)(ws + WS_G), (const bf16_t*)(ws + WL + W_DN2), MX, D, DFF,
                           pg8::EpiResid{KOUT(), (const float*)(ws + WS_XC), KOUT(), (float*)(ws + WS_XC), (const float*)(ws + MODL) + 8 * 1024, 0.5f}); }
    if (L == 0) { PH_BEGIN(); ctx_resid_gemm((const bf16_t*)(ws + WS_G), (const bf16_t*)(ws + WL + W_DN2), DFF, (float*)(ws + WS_XC), (const float*)(ws + MODL) + 2 * 9216 + 8 * 1024, 0.5f, gw, NGW, lane); }
    GSYNC(10);
}

__global__ void __launch_bounds__(NTHREADS, 2) mega_fwd(Args a) {
    extern __shared__ __attribute__((aligned(16))) unsigned char lds_raw[];
    cg::grid_group grid = cg::this_grid();
    LAS unsigned char* lds = (LAS unsigned char*)lds_raw;
    if (threadIdx.x < 2) ((volatile LAS unsigned*)(lds + LDS_BARST))[threadIdx.x] = 0u;
    __syncthreads();
    { const kptr_t kp = kargs(); (void)xcd_barrier_post((unsigned*)(KPTR(unsigned char, 23) + CTL_XBAR), (volatile LAS unsigned*)(lds + LDS_BARST)); }
    { PH_BEGIN(); prologue(kp, (LAS float*)(lds + wave * 16384), gw, NGW, lane); }
    if (gridDim.y == 0x7fffffffu) grid.sync();
    xbar(lds);
    layer_fwd<0>(grid, lds);
    layer_fwd<1>(grid, lds);
    { PH_BEGIN(); final_norm(KOUT(), KIN(21), gw, NGW, lane); }
}

extern "C" void kernel_launch(void* const* d_in, const int* in_sizes, int n_in, void* d_out, int out_size, void* d_ws, size_t ws_size, hipStream_t stream) {
    static int grid = 0;
    if (grid == 0) {
        if (n_in != 22 || out_size != MX * D || ws_size < WS_END) { fprintf(stderr, "kernel_launch: unexpected problem (n_in %d, out %d, ws %zu)\n", n_in, out_size, ws_size); grid = -1; return; }
        int dev = 0, cus = 0, per_cu = 0;
        hipGetDevice(&dev); hipDeviceGetAttribute(&cus, hipDeviceAttributeMultiprocessorCount, dev);
        if (hipFuncSetAttribute((const void*)mega_fwd, hipFuncAttributeMaxDynamicSharedMemorySize, LDS_BYTES) != hipSuccess) { fprintf(stderr, "kernel_launch: hipFuncSetAttribute failed\n"); grid = -1; return; }
        if (hipOccupancyMaxActiveBlocksPerMultiprocessor(&per_cu, (const void*)mega_fwd, NTHREADS, LDS_BYTES) != hipSuccess || per_cu < 1) { fprintf(stderr, "kernel_launch: occupancy query gave %d\n", per_cu); per_cu = 1; }
        (void)hipGetLastError();
        grid = cus * per_cu;
        fprintf(stderr, "kernel_launch: grid %d (cus %d x %d)\n", grid, cus, per_cu);
    }
    if (grid < 0) return;
    hipMemsetAsync((char*)d_ws, 0, CTL_BYTES, stream);
    Args a{};
    for (int i = 0; i < 22; ++i) a.in[i] = (const float*)d_in[i];
    a.out = (float*)d_out; a.ws = (unsigned char*)d_ws;
    void* args[] = {&a};
    hipError_t e = hipLaunchCooperativeKernel((const void*)mega_fwd, dim3(grid), dim3(NTHREADS), args, LDS_BYTES, stream);
    if (e != hipSuccess) fprintf(stderr, "cooperative launch failed: %s (grid %d)\n", hipGetErrorString(e), grid);
}
```

```cpp
#include <hip/hip_runtime.h>
#include <hip/hip_cooperative_groups.h>
#include <cstdio>
#include <cstdint>
#include <cmath>
namespace pg8 {
#define PG8_LAS __attribute__((address_space(3)))
typedef unsigned short bf16_t;
typedef short bf16x8 __attribute__((ext_vector_type(8)));
typedef float f32x4 __attribute__((ext_vector_type(4)));
typedef unsigned u32x4 __attribute__((ext_vector_type(4)));
constexpr int BM = 256, BK = 64, HALF = 128, HTB = HALF * BK * 2  , STAGE_BYTES = 8 * HTB, NXCD = 8, WGM = 8;

__host__ __device__ __forceinline__ int lds_byte(int r, int c) { const int st = (r >> 4) * 2 + (c >> 5), rr = r & 15, cc = c & 31, ob = rr * 64 + cc * 2; return st * 1024 + (ob ^ (((ob >> 9) & 1) << 5)); }
__host__ __device__ __forceinline__ void stage_rc(int b, int& R, int& C) { const int st = b / 1024, sb = b % 1024, swz = sb ^ (((sb >> 9) & 1) << 5); R = (st >> 1) * 16 + swz / 64; C = (st & 1) * 32 + (swz % 64) / 2; }
__host__ __device__ __forceinline__ int perm32(int rho) { const int n = rho >> 4, i = rho & 15; return 8 * (i >> 2) + 4 * n + (i & 3); }

struct Unit { int pm, pn; };
struct Gemm { const bf16_t* A; const bf16_t* Bt; int M, N, K; };

struct StaticOrder {
    int nM, nN, nwg, G, c;
    __host__ __device__ void init(int M, int N, int G_, int c_) { nM = M / BM; nN = N / BM; nwg = nM * nN; G = G_; c = c_; }
    __host__ __device__ bool next(int i, Unit& u) const {
        const long L = (long)i * G + c; if (L >= nwg) return false;
        int wgid = (int)L; { const int q = nwg / NXCD, r = nwg % NXCD, xcd = wgid % NXCD, off = wgid / NXCD; wgid = (xcd < r ? xcd * (q + 1) : r * (q + 1) + (xcd - r) * q) + off; }
        const int nig = WGM * nN, gid = wgid / nig, fm = gid * WGM, gsz = (nM - fm) < WGM ? (nM - fm) : WGM;
        u.pm = fm + ((wgid % nig) % gsz); u.pn = (wgid % nig) / gsz; return true;
    }
    __device__ __forceinline__ void a_ready(const Unit&) const {}
    __device__ __forceinline__ void done(const Unit&) const {}
};

__device__ __forceinline__ unsigned cvt_pk_bf16(float lo, float hi) { unsigned r; asm volatile("v_cvt_pk_bf16_f32 %0, %1, %2" : "=v"(r) : "v"(lo), "v"(hi)); return r; }
constexpr int D_ = 1024, MX_ = 32768, MALL_ = 33280, DFF_ = 2816;
typedef float f32x2 __attribute__((ext_vector_type(2)));
__device__ __forceinline__ float fast_sigmoid(float x) { return __builtin_amdgcn_rcpf(1.0f + __builtin_amdgcn_exp2f(-1.4426950408889634f * x)); }
__device__ __forceinline__ float silu_f(float x) { return x * fast_sigmoid(x); }
__device__ __forceinline__ float gelu_tanh(float x) { const float u = 1.5957691216057308f * (x + 0.044715f * x * x * x); return x * fast_sigmoid(u); }
__device__ __forceinline__ float bf2f(unsigned short b) { return __uint_as_float(((unsigned)b) << 16); }
__device__ __forceinline__ float bflo(unsigned w) { return __uint_as_float(w << 16); }
__device__ __forceinline__ float bfhi(unsigned w) { return __uint_as_float(w & 0xffff0000u); }
__device__ __forceinline__ unsigned short f2bf_rne(float f) { unsigned u = __float_as_uint(f); return (unsigned short)((u + 0x7fffu + ((u >> 16) & 1u)) >> 16); }

__device__ __forceinline__ u32x4 quad_swap(unsigned lo0, unsigned lo1, unsigned hi0, unsigned hi1, int fq, int& coloff) {
    const bool odd = fq & 1;
    const unsigned s0 = odd ? lo0 : hi0, s1 = odd ? lo1 : hi1;
    const unsigned r0 = (unsigned)__shfl_xor((int)s0, 16), r1 = (unsigned)__shfl_xor((int)s1, 16);
    coloff = odd ? 16 + 4 * (fq - 1) : 4 * fq;
    u32x4 o; o.x = odd ? r0 : lo0; o.y = odd ? r1 : lo1; o.z = odd ? hi0 : r0; o.w = odd ? hi1 : r1; return o;
}

struct EpiSwiGLU {
    static constexpr bool PERM = true, AFTER_DRAIN = false;
    bf16_t* O;
    __device__ __forceinline__ void operator()(const f32x4 (&acc)[2][2][4][2], const Unit& u, int wr, int wc, int fr, int fq) const {
        const int row0 = u.pm * BM + wr * 64 + fr, col0 = u.pn * HALF + wc * 32 + 8 * fq;
#pragma unroll
        for (int ai = 0; ai < 2; ++ai)
#pragma unroll
            for (int m = 0; m < 4; ++m) {
                bf16_t* p = O + (size_t)(row0 + ai * HALF + m * 16) * DFF_ + col0;
                const f32x4 a0 = acc[ai][0][m][0], a1 = acc[ai][0][m][1], b0 = acc[ai][1][m][0], b1 = acc[ai][1][m][1];
                float h[8];
#pragma unroll
                for (int e = 0; e < 4; ++e) { h[e] = silu_f(a0[e]) * b0[e]; h[4 + e] = silu_f(a1[e]) * b1[e]; }
                u32x4 w; w.x = cvt_pk_bf16(h[0], h[1]); w.y = cvt_pk_bf16(h[2], h[3]); w.z = cvt_pk_bf16(h[4], h[5]); w.w = cvt_pk_bf16(h[6], h[7]);
                *(u32x4*)p = w;
            }
    }
};

struct EpiResid {
    static constexpr bool PERM = false, AFTER_DRAIN = false;
    const float* src_main; const float* src_ctx; float* dst_main; float* dst_ctx; const float* gate_l  ; float coef;
    __device__ __forceinline__ void operator()(const f32x4 (&acc)[2][2][4][2], const Unit& u, int wr, int wc, int fr, int fq) const {
        const int cond = u.pm < 64 ? 0 : (u.pm < 128 ? 1 : 2);
        const float* gate = gate_l + cond * 9216;
        const int col0 = u.pn * BM + wc * 32 + 4 * fq;
        f32x4 gv[2][2];
#pragma unroll
        for (int bj = 0; bj < 2; ++bj)
#pragma unroll
            for (int n = 0; n < 2; ++n) gv[bj][n] = *(const f32x4*)(gate + col0 + bj * HALF + n * 16) * coef;
#pragma unroll
        for (int ai = 0; ai < 2; ++ai)
#pragma unroll
            for (int m = 0; m < 4; ++m) {
                const int row = u.pm * BM + ai * HALF + wr * 64 + m * 16 + fr;
                const float* s = row < MX_ ? src_main + (size_t)row * D_ : src_ctx + (size_t)(row - MX_) * D_;
                float* d = row < MX_ ? dst_main + (size_t)row * D_ : dst_ctx + (size_t)(row - MX_) * D_;
#pragma unroll
                for (int bj = 0; bj < 2; ++bj)
#pragma unroll
                    for (int n = 0; n < 2; ++n) { const int off = col0 + bj * HALF + n * 16; const f32x4 xo = *(const f32x4*)(s + off); *(f32x4*)(d + off) = xo + gv[bj][n] * acc[ai][bj][m][n]; }
            }
    }
};

struct EpiWin {
    static constexpr bool PERM = true, AFTER_DRAIN = false;
    bf16_t *QU, *KB, *VT, *VST, *GT; const float* bgate; const f32x4* ropeR; const f32x4* ropeC; float* stats; float qscale; PG8_LAS unsigned char* tl  ;
    __device__ __forceinline__ void operator()(const f32x4 (&acc)[2][2][4][2], const Unit& u, int wr, int wc, int fr, int fq) const {
        const int pn = u.pn, rowbase = u.pm * BM + wr * 64 + fr, cl = wc * 32 + 8 * fq;
        if (pn < 4) {
            const bool isq = pn < 2; bf16_t* O = isq ? QU : KB; const int ldo = isq ? 1024 : 512; const int cb = (pn & 1) * 256;
            const bool dorope = u.pm < 128; const float sc = isq ? qscale : 1.0f;
#pragma unroll
            for (int ai = 0; ai < 2; ++ai)
#pragma unroll
                for (int m = 0; m < 4; ++m) {
                    const int row = rowbase + ai * HALF + m * 16; const int t = row & 16383; const int pos = (wc & 1) ? (t & 63) : (t >> 6);
                    const f32x4* tab = ((wc & 1) ? ropeC : ropeR) + pos * 8 + 2 * fq;
                    f32x4 cs0 = (f32x4){1.f, 0.f, 1.f, 0.f}, cs1 = cs0;
                    if (dorope) { cs0 = tab[0]; cs1 = tab[1]; }
#pragma unroll
                    for (int bj = 0; bj < 2; ++bj) {
                        const f32x4 v0 = acc[ai][bj][m][0], v1 = acc[ai][bj][m][1];
                        float o[8];
                        o[0] = v0[0] * cs0[0] - v0[1] * cs0[1]; o[1] = v0[0] * cs0[1] + v0[1] * cs0[0];
                        o[2] = v0[2] * cs0[2] - v0[3] * cs0[3]; o[3] = v0[2] * cs0[3] + v0[3] * cs0[2];
                        o[4] = v1[0] * cs1[0] - v1[1] * cs1[1]; o[5] = v1[0] * cs1[1] + v1[1] * cs1[0];
                        o[6] = v1[2] * cs1[2] - v1[3] * cs1[3]; o[7] = v1[2] * cs1[3] + v1[3] * cs1[2];
                        u32x4 w; w.x = cvt_pk_bf16(o[0] * sc, o[1] * sc); w.y = cvt_pk_bf16(o[2] * sc, o[3] * sc); w.z = cvt_pk_bf16(o[4] * sc, o[5] * sc); w.w = cvt_pk_bf16(o[6] * sc, o[7] * sc);
                        const int cq = cb + bj * HALF + cl;
                        if (isq) *(u32x4*)(O + (size_t)row * 1024 + cq) = w;
                        else *(u32x4*)(O + ((size_t)(cq >> 6) * MALL_ + row) * 64 + (cq & 63)) = w;
                    }
                }
        } else if (pn < 6 || pn == 8 || pn == 9) {
            const bool isv = pn < 6; bf16_t* O = isv ? VT : VST; const int cb = (pn & 1) * 256;
            PG8_LAS unsigned char* T = tl + (wr * 4 + wc) * 2048;
            const int lane = fq * 16 + fr;
#pragma unroll
            for (int ai = 0; ai < 2; ++ai)
#pragma unroll
                for (int m = 0; m < 4; ++m) {
                    const int row = rowbase + ai * HALF + m * 16; float s1 = 0.f, s2 = 0.f;
#pragma unroll
                    for (int bj = 0; bj < 2; ++bj)
#pragma unroll
                        for (int n = 0; n < 2; ++n)
#pragma unroll
                            for (int e = 0; e < 4; ++e) {
                                float v = acc[ai][bj][m][n][e]; if (!isv) v = gelu_tanh(v);
                                const unsigned short b = f2bf_rne(v); const float vr = bf2f(b); s1 += vr; s2 += vr * vr;
                                *(PG8_LAS unsigned short*)(T + (bj * 32 + fq * 8 + n * 4 + e) * 32 + fr * 2) = b;
                            }
                    const int row16 = row - fr;
                    asm volatile("" ::: "memory");
#pragma unroll
                    for (int k = 0; k < 2; ++k) {
                        const int p = lane + 64 * k, cidx = p >> 1, half = p & 1;
                        const u32x4 w = *(const PG8_LAS u32x4*)(T + cidx * 32 + half * 16);
                        *(u32x4*)(O + ((size_t)((row16 >> 3) + half) * 512 + (cb + 128 * (cidx >> 5) + 32 * wc + (cidx & 31))) * 8) = w;
                    }
                    asm volatile("" ::: "memory");
                    if (!isv) {
                        s1 += __shfl_xor(s1, 16); s1 += __shfl_xor(s1, 32); s2 += __shfl_xor(s2, 16); s2 += __shfl_xor(s2, 32);
                        if (fq == 0) { unsafeAtomicAdd(stats + 2 * row, s1); unsafeAtomicAdd(stats + 2 * row + 1, s2); }
                    }
                }
        } else if (pn < 8) {
            const int cb = 512 + (pn - 6) * 256;
#pragma unroll
            for (int ai = 0; ai < 2; ++ai)
#pragma unroll
                for (int m = 0; m < 4; ++m) {
                    const int row = rowbase + ai * HALF + m * 16;
#pragma unroll
                    for (int bj = 0; bj < 2; ++bj) {
                        const f32x4 v0 = acc[ai][bj][m][0], v1 = acc[ai][bj][m][1];
                        u32x4 w; w.x = cvt_pk_bf16(gelu_tanh(v0[0]), gelu_tanh(v0[1])); w.y = cvt_pk_bf16(gelu_tanh(v0[2]), gelu_tanh(v0[3]));
                        w.z = cvt_pk_bf16(gelu_tanh(v1[0]), gelu_tanh(v1[1])); w.w = cvt_pk_bf16(gelu_tanh(v1[2]), gelu_tanh(v1[3]));
                        *(u32x4*)(QU + (size_t)row * 1024 + cb + bj * HALF + cl) = w;
                    }
                }
        } else {
            const int cb = (pn - 10) * 256;
            f32x4 bg[2][2];
#pragma unroll
            for (int bj = 0; bj < 2; ++bj)
#pragma unroll
                for (int n = 0; n < 2; ++n) bg[bj][n] = *(const f32x4*)(bgate + cb + bj * HALF + cl + 4 * n);
#pragma unroll
            for (int ai = 0; ai < 2; ++ai)
#pragma unroll
                for (int m = 0; m < 4; ++m) {
                    const int row = rowbase + ai * HALF + m * 16;
#pragma unroll
                    for (int bj = 0; bj < 2; ++bj) {
                        const f32x4 v0 = acc[ai][bj][m][0] + bg[bj][0], v1 = acc[ai][bj][m][1] + bg[bj][1];
                        u32x4 w; w.x = cvt_pk_bf16(fast_sigmoid(v0[0]), fast_sigmoid(v0[1])); w.y = cvt_pk_bf16(fast_sigmoid(v0[2]), fast_sigmoid(v0[3]));
                        w.z = cvt_pk_bf16(fast_sigmoid(v1[0]), fast_sigmoid(v1[1])); w.w = cvt_pk_bf16(fast_sigmoid(v1[2]), fast_sigmoid(v1[3]));
                        *(u32x4*)(GT + (size_t)row * 2048 + cb + bj * HALF + cl) = w;
                    }
                }
        }
    }
};

struct EpiMerge {
    static constexpr bool PERM = true, AFTER_DRAIN = false;
    const bf16_t* GT; bf16_t* MRG;
    __device__ __forceinline__ void operator()(const f32x4 (&acc)[2][2][4][2], const Unit& u, int wr, int wc, int fr, int fq) const {
        const int row0 = u.pm * BM + wr * 64 + fr, col0 = u.pn * HALF + wc * 32 + 8 * fq;
#pragma unroll
        for (int ai = 0; ai < 2; ++ai)
#pragma unroll
            for (int m = 0; m < 4; ++m) {
                const int row = row0 + ai * HALF + m * 16;
                const u32x4 ga = *(const u32x4*)(GT + (size_t)row * 2048 + col0), gb = *(const u32x4*)(GT + (size_t)row * 2048 + 1024 + col0);
                const f32x4 a0 = acc[ai][0][m][0], a1 = acc[ai][0][m][1], b0 = acc[ai][1][m][0], b1 = acc[ai][1][m][1];
                u32x4 w;
                w.x = cvt_pk_bf16(bflo(ga.x) * a0[0] + bflo(gb.x) * b0[0], bfhi(ga.x) * a0[1] + bfhi(gb.x) * b0[1]);
                w.y = cvt_pk_bf16(bflo(ga.y) * a0[2] + bflo(gb.y) * b0[2], bfhi(ga.y) * a0[3] + bfhi(gb.y) * b0[3]);
                w.z = cvt_pk_bf16(bflo(ga.z) * a1[0] + bflo(gb.z) * b1[0], bfhi(ga.z) * a1[1] + bfhi(gb.z) * b1[1]);
                w.w = cvt_pk_bf16(bflo(ga.w) * a1[2] + bflo(gb.w) * b1[2], bfhi(ga.w) * a1[3] + bfhi(gb.w) * b1[3]);
                *(u32x4*)(MRG + (size_t)row * 1024 + col0) = w;
            }
    }
};

template <class Epi, class Sched, bool ALIGN_EPI = false, bool SP2 = false>
__device__ __forceinline__ void gemm_phase(PG8_LAS unsigned char* lds, const Gemm g, const Sched& S, const Epi& E) {
    int tid_ = threadIdx.x; asm volatile("" : "+v"(tid_));
    const int tid = tid_, wid = __builtin_amdgcn_readfirstlane(tid >> 6), lane = tid & 63, wr = wid >> 2, wc = wid & 3, fr = lane & 15, fq = lane >> 4;
    const int K = g.K, nt = K / BK;
    unsigned voffA[2], voffB[2];
#pragma unroll
    for (int i = 0; i < 2; ++i) { int R, C; stage_rc(tid * 16 + i * 8192, R, C); const int Rb = Epi::PERM ? ((R & ~31) + perm32(R & 31)) : R;
        voffA[i] = (unsigned)(R * K + C) * 2u; voffB[i] = (unsigned)(Rb * K + C) * 2u; }
    const size_t kstep = (size_t)(BK * 2);
    const size_t hstep = (size_t)HALF * K * 2;
    const size_t tstep = 2 * hstep;
    const unsigned ldsw = (unsigned)wid * 1024u;
    const int aoff = lds_byte(wr * 64 + fr, fq * 8), boff = lds_byte(wc * 32 + fr, fq * 8);
#define PG8_SA(b, h) (((b) * 2 + (h)) * HTB)
#define PG8_SB(b, h) ((4 + (b) * 2 + (h)) * HTB)
#define PG8_STAGE(bufoff, gbase, voff) do { _Pragma("unroll") for (int _i = 0; _i < 2; ++_i) \
        __builtin_amdgcn_global_load_lds((const unsigned*)((const char*)(gbase) + (voff)[_i]), (PG8_LAS unsigned*)(lds + (bufoff) + ldsw + _i * 8192), 16, 0, 0); } while (0)
#define PG8_LDA(dst, b, h) do { _Pragma("unroll") for (int m = 0; m < 4; ++m) _Pragma("unroll") for (int k = 0; k < 2; ++k) dst[m][k] = *(const PG8_LAS bf16x8*)(lds + PG8_SA(b, h) + aoff + m * 2048 + k * 1024); } while (0)
#define PG8_LDB(dst, b, h) do { _Pragma("unroll") for (int n = 0; n < 2; ++n) _Pragma("unroll") for (int k = 0; k < 2; ++k) dst[n][k] = *(const PG8_LAS bf16x8*)(lds + PG8_SB(b, h) + boff + n * 2048 + k * 1024); } while (0)
#define PG8_MMA(ai, bj, At, Bt) do { __builtin_amdgcn_s_setprio(1); _Pragma("unroll") for (int m = 0; m < 4; ++m) _Pragma("unroll") for (int n = 0; n < 2; ++n) _Pragma("unroll") for (int k = 0; k < 2; ++k) \
        acc[ai][bj][m][n] = __builtin_amdgcn_mfma_f32_16x16x32_bf16(Bt[n][k], At[m][k], acc[ai][bj][m][n], 0, 0, 0); __builtin_amdgcn_s_setprio(0); } while (0)
#define PG8_WAIT_V(n) asm volatile("s_waitcnt vmcnt(" #n ")" ::: "memory")
#define PG8_WAIT_L(n) asm volatile("s_waitcnt lgkmcnt(" #n ")" ::: "memory")
#define PG8_BAR __builtin_amdgcn_s_barrier()
#define PG8_SCHED __builtin_amdgcn_sched_barrier(0)
    Unit cur, nxt; int ui = 0;
    if (!S.next(0, cur)) return;
    f32x4 acc[2][2][4][2];
#pragma unroll
    for (int a = 0; a < 2; ++a)
#pragma unroll
        for (int b = 0; b < 2; ++b)
#pragma unroll
            for (int m = 0; m < 4; ++m)
#pragma unroll
                for (int n = 0; n < 2; ++n) acc[a][b][m][n] = (f32x4){0.f, 0.f, 0.f, 0.f};
    bf16x8 At[4][2], B0[2][2], B1[2][2];
    const char* cA = (const char*)g.A + (size_t)cur.pm * tstep; const char* cB = (const char*)g.Bt + (size_t)cur.pn * tstep;
    S.a_ready(cur);
    if constexpr (SP2) {
        PG8_STAGE(PG8_SB(0, 0), cB, voffB); PG8_STAGE(PG8_SB(0, 1), cB + hstep, voffB); PG8_STAGE(PG8_SA(0, 0), cA, voffA); PG8_STAGE(PG8_SA(0, 1), cA + hstep, voffA);
        if (wr == 1) PG8_BAR;
        PG8_WAIT_V(2); PG8_BAR;
        PG8_STAGE(PG8_SB(1, 0), cB + kstep, voffB); PG8_STAGE(PG8_SA(1, 0), cA + kstep, voffA); PG8_STAGE(PG8_SB(1, 1), cB + hstep + kstep, voffB);
        PG8_WAIT_V(6); PG8_BAR;
    } else {
        PG8_STAGE(PG8_SB(0, 0), cB, voffB); PG8_STAGE(PG8_SA(0, 0), cA, voffA); PG8_STAGE(PG8_SB(0, 1), cB + hstep, voffB); PG8_STAGE(PG8_SA(0, 1), cA + hstep, voffA);
        if (wr == 1) PG8_BAR;
        PG8_WAIT_V(4); PG8_BAR;
        PG8_STAGE(PG8_SB(1, 0), cB + kstep, voffB); PG8_STAGE(PG8_SA(1, 0), cA + kstep, voffA); PG8_STAGE(PG8_SB(1, 1), cB + hstep + kstep, voffB);
        PG8_WAIT_V(6); PG8_BAR;
    }
    for (;;) {
        const bool has_next = S.next(ui + 1, nxt);
        const char* nA = has_next ? (const char*)g.A + (size_t)nxt.pm * tstep : cA; const char* nB = has_next ? (const char*)g.Bt + (size_t)nxt.pn * tstep : cB;
        for (int t = 0; t < nt; t += 2) {
            const bool last = (t == nt - 2);
            const char* a1 = cA + (size_t)(t + 1) * kstep;
            const char* a2 = last ? nA : cA + (size_t)(t + 2) * kstep; const char* b2 = last ? nB : cB + (size_t)(t + 2) * kstep;
            const char* a3 = a2 + kstep; const char* b3 = b2 + kstep;
            if (last && has_next) S.a_ready(nxt);
            if constexpr (SP2) {
            PG8_LDB(B0, 0, 0); PG8_LDB(B1, 0, 1); PG8_SCHED; PG8_LDA(At, 0, 0); PG8_STAGE(PG8_SA(1, 1), a1 + hstep, voffA);
            PG8_WAIT_V(8); PG8_WAIT_L(0); PG8_BAR; PG8_MMA(0, 0, At, B0); PG8_MMA(0, 1, At, B1); PG8_BAR; PG8_SCHED;
            PG8_LDA(At, 0, 1); PG8_STAGE(PG8_SB(0, 0), b2, voffB); PG8_STAGE(PG8_SB(0, 1), b2 + hstep, voffB); PG8_STAGE(PG8_SA(0, 0), a2, voffA);
            PG8_WAIT_V(8); PG8_WAIT_L(0); PG8_BAR; PG8_MMA(1, 0, At, B0); PG8_MMA(1, 1, At, B1); PG8_BAR; PG8_SCHED;
            PG8_LDB(B0, 1, 0); PG8_LDB(B1, 1, 1); PG8_SCHED; PG8_LDA(At, 1, 0); PG8_STAGE(PG8_SA(0, 1), a2 + hstep, voffA);
            PG8_WAIT_V(8); PG8_WAIT_L(0); PG8_BAR; PG8_MMA(0, 0, At, B0); PG8_MMA(0, 1, At, B1); PG8_BAR; PG8_SCHED;
            PG8_LDA(At, 1, 1); PG8_STAGE(PG8_SB(1, 0), b3, voffB); PG8_STAGE(PG8_SB(1, 1), b3 + hstep, voffB); PG8_STAGE(PG8_SA(1, 0), a3, voffA);
            PG8_WAIT_V(8); PG8_WAIT_L(0); PG8_BAR; PG8_MMA(1, 0, At, B0); PG8_MMA(1, 1, At, B1); PG8_BAR; PG8_SCHED;
            } else {
            PG8_LDB(B0, 0, 0); PG8_SCHED; PG8_LDA(At, 0, 0); PG8_STAGE(PG8_SA(1, 1), a1 + hstep, voffA);
            PG8_WAIT_L(8); PG8_BAR; PG8_WAIT_L(0); PG8_MMA(0, 0, At, B0); PG8_BAR; PG8_SCHED;
            PG8_LDB(B1, 0, 1); PG8_STAGE(PG8_SB(0, 0), b2, voffB);
            PG8_BAR; PG8_WAIT_L(0); PG8_MMA(0, 1, At, B1); PG8_BAR;
            PG8_LDA(At, 0, 1); PG8_STAGE(PG8_SA(0, 0), a2, voffA);
            PG8_BAR; PG8_WAIT_L(0); PG8_MMA(1, 0, At, B0); PG8_BAR; PG8_SCHED;
            PG8_STAGE(PG8_SB(0, 1), b2 + hstep, voffB);
            PG8_WAIT_V(6); PG8_BAR; PG8_MMA(1, 1, At, B1); PG8_BAR;
            PG8_LDB(B0, 1, 0); PG8_SCHED; PG8_LDA(At, 1, 0); PG8_STAGE(PG8_SA(0, 1), a2 + hstep, voffA);
            PG8_WAIT_L(8); PG8_BAR; PG8_WAIT_L(0); PG8_MMA(0, 0, At, B0); PG8_BAR; PG8_SCHED;
            PG8_LDB(B1, 1, 1); PG8_STAGE(PG8_SB(1, 0), b3, voffB);
            PG8_BAR; PG8_WAIT_L(0); PG8_MMA(0, 1, At, B1); PG8_BAR;
            PG8_LDA(At, 1, 1); PG8_STAGE(PG8_SA(1, 0), a3, voffA);
            PG8_BAR; PG8_WAIT_L(0); PG8_MMA(1, 0, At, B0); PG8_BAR; PG8_SCHED;
            PG8_STAGE(PG8_SB(1, 1), b3 + hstep, voffB);
            PG8_WAIT_V(6); PG8_BAR; PG8_MMA(1, 1, At, B1); PG8_BAR;
            }
        }
        if constexpr (ALIGN_EPI) { if (wr == 0) PG8_BAR; }
        if constexpr (!Epi::AFTER_DRAIN) { E(acc, cur, wr, wc, fr, fq); S.done(cur); }
        if (!has_next) break;
#pragma unroll
        for (int a = 0; a < 2; ++a)
#pragma unroll
            for (int b = 0; b < 2; ++b)
#pragma unroll
                for (int m = 0; m < 4; ++m)
#pragma unroll
                    for (int n = 0; n < 2; ++n) acc[a][b][m][n] = (f32x4){0.f, 0.f, 0.f, 0.f};
        cur = nxt; cA = nA; cB = nB; ++ui;
        if constexpr (ALIGN_EPI) { if (wr == 1) PG8_BAR; }
    }
    PG8_WAIT_V(0);
    if constexpr (!ALIGN_EPI) { if (wr == 0) PG8_BAR; }
    PG8_BAR;
    if constexpr (Epi::AFTER_DRAIN) { E.fused(acc, cur, wr, wc, fr, fq, lds, wid, lane); S.done(cur); }
#undef PG8_SA
#undef PG8_SB
#undef PG8_STAGE
#undef PG8_LDA
#undef PG8_LDB
#undef PG8_MMA
#undef PG8_WAIT_V
#undef PG8_WAIT_L
#undef PG8_BAR
#undef PG8_SCHED
}
}

namespace cg = cooperative_groups;
using pg8::bf16_t; using pg8::bf16x8; using pg8::f32x4; using pg8::u32x4;
#define LAS __attribute__((address_space(3)))
typedef unsigned u32x2 __attribute__((ext_vector_type(2)));
constexpr int D = 1024, MX = 32768, MALL = 33280, DFF = 2816, INC = 4608;
constexpr int NWAVES = 8, NTHREADS = 512, LDS_BYTES = 163840;
constexpr float EPS = 1e-6f, LOG2E = 1.4426950408889634f, QSCALE = 0.125f * 1.4426950408889634f;

constexpr size_t MiB = 1u << 20;
constexpr size_t CTL_MOD = 0;
constexpr size_t CTL_STATS = 221184;
constexpr size_t CTL_ROPE = 753664;
constexpr size_t CTL_CNT = 794624;
constexpr size_t CTL_BAR = 802816;
constexpr size_t CTL_XBAR = 819200;
constexpr size_t CTL_BYTES = 1 * MiB;
constexpr int LDS_BARST = 163840 - 64;
constexpr int LDS_CK = 0, LDS_CV = 65536, LDS_RPB = 131072, LDS_OT = 145952;
static_assert(LDS_OT + 16384 <= LDS_BARST && LDS_RPB + 8 * 465 * 4 <= LDS_OT, "attention LDS map");
static_assert(CTL_STATS == 2 * 3 * 9216 * 4 && CTL_ROPE == CTL_STATS + 2 * 33280 * 2 * 4 && CTL_CNT == CTL_ROPE + 320 * 128 && CTL_CNT + 8 * 256 <= CTL_BYTES, "ctl map");
constexpr size_t WS_W = 1 * MiB, W_LAYER = 49 * MiB;
constexpr size_t W_UP1 = 0, W_DN1 = 11 * MiB, W_IN = W_DN1 + 5 * MiB + MiB / 2, W_PAB = W_IN + 9 * MiB, W_O = W_PAB + 4 * MiB, W_UP2 = W_O + 2 * MiB, W_DN2 = W_UP2 + 11 * MiB, W_S = W_DN2 + 5 * MiB + MiB / 2;
static_assert(W_S + 131072 <= W_LAYER, "weights map");
constexpr size_t WS_XC = WS_W + 2 * W_LAYER;
constexpr size_t WS_H = WS_XC + 2 * MiB;
constexpr size_t WS_MIX = WS_H + 65 * MiB;
constexpr size_t WS_QU = WS_MIX;
constexpr size_t WS_KB = WS_QU + 65 * MiB;
constexpr size_t WS_VT = WS_KB + 32 * MiB + MiB / 2;
constexpr size_t WS_VST = WS_VT + 32 * MiB + MiB / 2;
constexpr size_t WS_GT = WS_VST + 32 * MiB + MiB / 2;
constexpr size_t WS_END = WS_GT + 130 * MiB;
constexpr size_t WS_MRG = WS_KB;
constexpr size_t WS_G = WS_MIX;
static_assert((size_t)MALL * DFF * 2 <= WS_END - WS_MIX && WS_END <= 512 * MiB, "ws map");

struct Args { const float* in[22]; float* out; unsigned char* ws; };
typedef const __attribute__((address_space(4))) unsigned long long* kptr_t;
#define GAS __attribute__((address_space(1)))
#define KPTR(T, i) ((T*)(GAS T*)kp[(i)])

__device__ __forceinline__ float wave_sum(float v) {
#pragma unroll
    for (int o = 1; o < 64; o <<= 1) v += __shfl_xor(v, o);
    return v;
}
typedef float f32x2_t __attribute__((ext_vector_type(2))); typedef __bf16 bf16x2_t __attribute__((ext_vector_type(2)));
__device__ __forceinline__ unsigned cvtpk_s(float lo, float hi) { f32x2_t v = {lo, hi}; bf16x2_t b = __builtin_convertvector(v, bf16x2_t); return __builtin_bit_cast(unsigned, b); }
#define LDS_WAIT() asm volatile("s_waitcnt lgkmcnt(0)" ::: "memory")

__device__ __forceinline__ void transpose_item(const float* W, int N, bf16_t* WT, int ldw, int drow0, int dk0, LAS float* scr, int k0, int n0, int lane) {
#pragma unroll 8
    for (int i = 0; i < 32; ++i) { const int kk = 2 * i + (lane >> 5); scr[kk * 33 + (lane & 31)] = W[(size_t)(k0 + kk) * N + n0 + (lane & 31)]; }
    LDS_WAIT(); asm volatile("" ::: "memory");
    const int c = lane & 7;
#pragma unroll
    for (int j = 0; j < 4; ++j) { const int n = (lane >> 3) + 8 * j; const LAS float* s = scr + (8 * c) * 33 + n;
        u32x4 o; o.x = cvtpk_s(s[0 * 33], s[1 * 33]); o.y = cvtpk_s(s[2 * 33], s[3 * 33]); o.z = cvtpk_s(s[4 * 33], s[5 * 33]); o.w = cvtpk_s(s[6 * 33], s[7 * 33]);
        *(u32x4*)(WT + (size_t)(drow0 + n) * ldw + dk0 + k0 + 8 * c) = o; }
    LDS_WAIT(); asm volatile("" ::: "memory");
}
__device__ __forceinline__ int up_row(int n0) { return n0 < DFF ? 256 * (n0 / 128) + (n0 % 128) : 256 * ((n0 - DFF) / 128) + 128 + ((n0 - DFF) % 128); }

constexpr int IT_UP = 16 * 176, IT_DN = 44 * 32, IT_IN = 16 * 144, IT_P = 8 * 32, IT_O = 16 * 32, IT_Z = 2048, IT_S = 128;
constexpr int IT_LAYER = 2 * IT_UP + 2 * IT_DN + IT_IN + 2 * IT_P + IT_O + IT_Z + IT_S;
constexpr int IT_ADA = 2 * 36 * 16, IT_XC = 2048, IT_ROPE = 80;
constexpr int IT_TOTAL = IT_ADA + 2 * IT_LAYER + IT_XC + IT_ROPE;

__device__ __forceinline__ void prologue(const kptr_t kp, LAS float* scr, int gw, int NGW, int lane) {
    unsigned char* ws = KPTR(unsigned char, 23);
    for (int it = gw; it < IT_TOTAL; it += NGW) {
        int r = it;
        if (r < IT_ADA) {
            const int l = r / 576, rem = r % 576, cgp = rem / 16, ks = rem % 16, j0 = cgp * 256 + 4 * lane;
            const float* c = KPTR(const float, 1); const float* cc = KPTR(const float, 3);
            const float* wp = KPTR(const float, 4) + ((size_t)l * 1024 + ks * 64) * 9216 + j0;
            f32x4 a0 = {0.f, 0.f, 0.f, 0.f}, a1 = a0, a2 = a0;
#pragma unroll 4
            for (int kk = 0; kk < 64; ++kk) {
                const int k = ks * 64 + kk; const float x0 = c[k], x1 = c[1024 + k], x2 = cc[k];
                const float s0 = x0 / (1.0f + expf(-x0)), s1 = x1 / (1.0f + expf(-x1)), s2 = x2 / (1.0f + expf(-x2));
                const f32x4 w = *(const f32x4*)(wp + (size_t)kk * 9216);
                a0 += w * s0; a1 += w * s1; a2 += w * s2;
            }
            if (ks == 0) { const f32x4 b = *(const f32x4*)(KPTR(const float, 5) + l * 9216 + j0); a0 += b; a1 += b; a2 += b; }
            float* m = (float*)(ws + CTL_MOD) + (size_t)l * 3 * 9216 + j0;
#pragma unroll
            for (int e = 0; e < 4; ++e) { unsafeAtomicAdd(m + e, a0[e]); unsafeAtomicAdd(m + 9216 + e, a1[e]); unsafeAtomicAdd(m + 18432 + e, a2[e]); }
            continue;
        }
        r -= IT_ADA;
        if (r < 2 * IT_LAYER) {
            const int l = r / IT_LAYER; r -= l * IT_LAYER;
            unsigned char* wl = ws + WS_W + (size_t)l * W_LAYER;
            if (r < IT_UP) { const int kb = r / 176, nb = r % 176; transpose_item(KPTR(const float, 7) + (size_t)l * D * 2 * DFF, 2 * DFF, (bf16_t*)(wl + W_UP1), D, up_row(32 * nb), 0, scr, 64 * kb, 32 * nb, lane); continue; } r -= IT_UP;
            if (r < IT_DN) { const int kb = r / 32, nb = r % 32; transpose_item(KPTR(const float, 8) + (size_t)l * DFF * D, D, (bf16_t*)(wl + W_DN1), DFF, 32 * nb, 0, scr, 64 * kb, 32 * nb, lane); continue; } r -= IT_DN;
            if (r < IT_IN) { const int kb = r / 144, nb = r % 144; transpose_item(KPTR(const float, 9) + (size_t)l * D * INC, INC, (bf16_t*)(wl + W_IN), D, 32 * nb, 0, scr, 64 * kb, 32 * nb, lane); continue; } r -= IT_IN;
            if (r < IT_P) { const int kb = r / 32, nb = r % 32, n0 = 32 * nb; transpose_item(KPTR(const float, 16) + (size_t)l * 512 * D, D, (bf16_t*)(wl + W_PAB), D, 256 * (n0 / 128) + (n0 % 128), 0, scr, 64 * kb, n0, lane); continue; } r -= IT_P;
            if (r < IT_P) { const int kb = r / 32, nb = r % 32, n0 = 32 * nb; transpose_item(KPTR(const float, 17) + (size_t)l * 512 * D, D, (bf16_t*)(wl + W_PAB), D, 256 * (n0 / 128) + 128 + (n0 % 128), 512, scr, 64 * kb, n0, lane); continue; } r -= IT_P;
            if (r < IT_O) { const int kb = r / 32, nb = r % 32; transpose_item(KPTR(const float, 18) + (size_t)l * D * D, D, (bf16_t*)(wl + W_O), D, 32 * nb, 0, scr, 64 * kb, 32 * nb, lane); continue; } r -= IT_O;
            if (r < IT_UP) { const int kb = r / 176, nb = r % 176; transpose_item(KPTR(const float, 19) + (size_t)l * D * 2 * DFF, 2 * DFF, (bf16_t*)(wl + W_UP2), D, up_row(32 * nb), 0, scr, 64 * kb, 32 * nb, lane); continue; } r -= IT_UP;
            if (r < IT_DN) { const int kb = r / 32, nb = r % 32; transpose_item(KPTR(const float, 20) + (size_t)l * DFF * D, D, (bf16_t*)(wl + W_DN2), DFF, 32 * nb, 0, scr, 64 * kb, 32 * nb, lane); continue; } r -= IT_DN;
            if (r < IT_Z) {
                const int zk0 = ((r & 255) < 128) ? 512 : 0;
                *(u32x4*)((bf16_t*)(wl + W_PAB) + (size_t)r * D + zk0 + 8 * lane) = (u32x4){0u, 0u, 0u, 0u}; continue; } r -= IT_Z;
            {
                const float* s = KPTR(const float, 14) + (size_t)l * 65536 + (size_t)(r * 64 + lane) * 8; const f32x4 v0 = *(const f32x4*)s, v1 = *(const f32x4*)(s + 4);
                u32x4 o; o.x = cvtpk_s(v0[0], v0[1]); o.y = cvtpk_s(v0[2], v0[3]); o.z = cvtpk_s(v1[0], v1[1]); o.w = cvtpk_s(v1[2], v1[3]);
                *(u32x4*)((bf16_t*)(wl + W_S) + (size_t)(r * 64 + lane) * 8) = o; continue; }
        }
        r -= 2 * IT_LAYER;
        if (r < IT_XC) { const size_t idx = (size_t)(r * 64 + lane) * 4; *(f32x4*)((float*)(ws + WS_XC) + idx) = *(const f32x4*)(KPTR(const float, 2) + idx); continue; }
        r -= IT_XC;
        {
            const int id = r * 64 + lane, pos = id >> 4, j = id & 15; const int p = pos < 256 ? pos : pos - 256;
            const float freq = powf(10000.0f, -(float)j / 16.0f); const float ang = (float)p * freq;
            float* t = (float*)(ws + CTL_ROPE) + (size_t)id * 2; t[0] = cosf(ang); t[1] = sinf(ang);
        }
    }
}

__device__ __forceinline__ void modpass(const float* xs_main, const float* xs_ctx, const float* mod_l, const float* g, int i, bf16_t* H, int nrows, int gw, int NGW, int lane) {
    for (int row = gw; row < nrows; row += NGW) {
        const float* xr = row < MX ? xs_main + (size_t)row * D : xs_ctx + (size_t)(row - MX) * D;
        const int cond = row < 16384 ? 0 : (row < MX ? 1 : 2);
        const float* shift = mod_l + cond * 9216 + 3 * i * 1024; const float* scale = shift + 1024;
        f32x4 v[4]; float ss = 0.f;
#pragma unroll
        for (int j = 0; j < 4; ++j) { v[j] = *(const f32x4*)(xr + 4 * lane + 256 * j); ss += (v[j][0] * v[j][0] + v[j][1] * v[j][1]) + (v[j][2] * v[j][2] + v[j][3] * v[j][3]); }
        const float rstd = 1.0f / sqrtf(wave_sum(ss) * (1.0f / D) + EPS);
#pragma unroll
        for (int j = 0; j < 4; ++j) {
            const int c = 4 * lane + 256 * j; const f32x4 gg = *(const f32x4*)(g + c), sc = *(const f32x4*)(scale + c), sh = *(const f32x4*)(shift + c);
            const f32x4 o = v[j] * rstd * gg * (sc + 1.0f) + sh;
            u32x2 w; w.x = cvtpk_s(o[0], o[1]); w.y = cvtpk_s(o[2], o[3]);
            *(u32x2*)(H + (size_t)row * D + c) = w;
        }
    }
}
__device__ __forceinline__ void final_norm(float* out, const float* g, int gw, int NGW, int lane) {
    for (int row = gw; row < MX; row += NGW) {
        float* xr = out + (size_t)row * D; f32x4 v[4]; float ss = 0.f;
#pragma unroll
        for (int j = 0; j < 4; ++j) { v[j] = *(const f32x4*)(xr + 4 * lane + 256 * j); ss += (v[j][0] * v[j][0] + v[j][1] * v[j][1]) + (v[j][2] * v[j][2] + v[j][3] * v[j][3]); }
        const float rstd = 1.0f / sqrtf(wave_sum(ss) * (1.0f / D) + EPS);
#pragma unroll
        for (int j = 0; j < 4; ++j) { const int c = 4 * lane + 256 * j; *(f32x4*)(xr + c) = v[j] * rstd * *(const f32x4*)(g + c); }
    }
}

#define MFMA16(a, b, c) __builtin_amdgcn_mfma_f32_16x16x32_bf16((a), (b), (c), 0, 0, 0)
__device__ __forceinline__ int wq_next(unsigned* cnt, int lane) { unsigned v = 0u; if (lane == 0) v = atomicAdd(cnt, 1u); return (int)__builtin_amdgcn_readfirstlane(v); }

__device__ __forceinline__ void attn_unit(int u, const bf16_t* KB, const bf16_t* VT, const bf16_t* QU, bf16_t* OB, const LAS float* rpb_l, LAS unsigned char* ot, const LAS unsigned char* ckl, const LAS unsigned char* cvl, int lane_) {
    int lane = lane_; asm volatile("" : "+v"(lane));
    const int fr = lane & 15, fq = lane >> 4;
    const bool isx = u < 16384;
    int b, h, cb, r = 0, qrow0, rs = 0, c0 = 0;
    if (isx) { cb = u & 3; h = (u >> 2) & 7; r = (u >> 5) & 255; b = u >> 13; qrow0 = b * 16384 + r * 64 + 16 * cb; rs = min(max(r - 4, 0), 248); c0 = (cb == 0) ? 0 : (cb == 1 ? 8 : (cb == 2 ? 24 : 32)); }
    else { const int uu = u - 16384; cb = uu & 3; h = (uu >> 2) & 7; const int rg = (uu >> 5) & 3; b = uu >> 7; qrow0 = MX + b * 256 + rg * 64 + 16 * cb; }
    bf16x8 bq0, bq1; { const bf16_t* qp = QU + (size_t)(qrow0 + fr) * 1024 + h * 64 + 8 * fq; bq0 = *(const bf16x8*)qp; bq1 = *(const bf16x8*)(qp + 32); }
    const int kk0 = 8 * (fr >> 2) + (fr & 3);
    const f32x4 z4 = {0.f, 0.f, 0.f, 0.f};
    const float NEG = -INFINITY;
    f32x4 st[8][2];
    f32x4 o[4] = {z4, z4, z4, z4};
    float m = NEG, l = 0.f;
    bf16x8 fb[32];
#define ATTN_SB() __builtin_amdgcn_sched_barrier(0)
    if (isx) {
        const bf16_t* kp0 = KB + ((size_t)h * MALL + (b * 16384 + rs * 64 + c0 + kk0)) * 64 + 8 * fq;
#pragma unroll
        for (int i = 0; i < 8; ++i)
#pragma unroll
            for (int t = 0; t < 2; ++t) { const bf16_t* kp = kp0 + (size_t)(i * 64 + 4 * t) * 64; fb[i * 4 + t * 2] = *(const bf16x8*)kp; fb[i * 4 + t * 2 + 1] = *(const bf16x8*)(kp + 32); }
        ATTN_SB();
#pragma unroll
        for (int i = 0; i < 8; ++i)
#pragma unroll
            for (int t = 0; t < 2; ++t) { f32x4 s = MFMA16(fb[i * 4 + t * 2], bq0, z4); s = MFMA16(fb[i * 4 + t * 2 + 1], bq1, s); st[i][t] = s; }
        ATTN_SB();
        const bf16_t* vp0 = VT + ((size_t)(((b * 16384 + rs * 64 + c0) >> 3) + fq) * 512 + h * 64 + fr) * 8;
#pragma unroll
        for (int i = 0; i < 8; ++i)
#pragma unroll
            for (int dt = 0; dt < 4; ++dt) fb[i * 4 + dt] = *(const bf16x8*)(vp0 + (size_t)(i * 8 * 512 + dt * 16) * 8);
        ATTN_SB();
        const int c = 16 * cb + fr, cs = min(max(c - 8, 0), 48); const LAS float* rp = rpb_l + h * 465 + (rs - r + 7) * 31;
#pragma unroll
        for (int t = 0; t < 2; ++t)
#pragma unroll
            for (int e = 0; e < 4; ++e) { const int kc = c0 + 8 * fq + 4 * t + e; const bool valid = (kc >= cs) && (kc < cs + 16); const int dc = min(max(kc - c + 15, 0), 30);
                float bz[8];
#pragma unroll
                for (int i = 0; i < 8; ++i) bz[i] = rp[i * 31 + dc];
                asm volatile("" : "+v"(bz[0]), "+v"(bz[1]), "+v"(bz[2]), "+v"(bz[3]), "+v"(bz[4]), "+v"(bz[5]), "+v"(bz[6]), "+v"(bz[7]));
#pragma unroll
                for (int i = 0; i < 8; ++i) st[i][t][e] = valid ? st[i][t][e] + bz[i] : NEG; }
#pragma unroll
        for (int g = 0; g < 8; ++g)
#pragma unroll
            for (int t = 0; t < 2; ++t) m = fmaxf(m, fmaxf(fmaxf(st[g][t][0], st[g][t][1]), fmaxf(st[g][t][2], st[g][t][3])));
        m = fmaxf(m, __shfl_xor(m, 16)); m = fmaxf(m, __shfl_xor(m, 32));
#pragma unroll
        for (int g = 0; g < 8; ++g)
#pragma unroll
            for (int t = 0; t < 2; ++t)
#pragma unroll
                for (int e = 0; e < 4; ++e) { const float p = __builtin_amdgcn_exp2f(st[g][t][e] - m); st[g][t][e] = p; l += p; }
        ATTN_SB();
#pragma unroll
        for (int i = 0; i < 8; ++i) {
            u32x4 pw; pw.x = cvtpk_s(st[i][0][0], st[i][0][1]); pw.y = cvtpk_s(st[i][0][2], st[i][0][3]); pw.z = cvtpk_s(st[i][1][0], st[i][1][1]); pw.w = cvtpk_s(st[i][1][2], st[i][1][3]);
            const bf16x8 pa = __builtin_bit_cast(bf16x8, pw);
#pragma unroll
            for (int dt = 0; dt < 4; ++dt) o[dt] = MFMA16(pa, fb[i * 4 + dt], o[dt]);
        }
        ATTN_SB();
    }
    {
        {
            const int sw = (fr >> 2) * 2 + ((fr >> 1) & 1);
            const LAS unsigned char* k0 = ckl + kk0 * 128 + ((fq ^ sw) << 4); const LAS unsigned char* k1 = ckl + kk0 * 128 + (((fq + 4) ^ sw) << 4);
#pragma unroll
            for (int j = 0; j < 8; ++j)
#pragma unroll
                for (int t = 0; t < 2; ++t) { fb[j * 4 + t * 2] = *(const LAS bf16x8*)(k0 + j * 4096 + t * 512); fb[j * 4 + t * 2 + 1] = *(const LAS bf16x8*)(k1 + j * 4096 + t * 512); }
        }
        ATTN_SB();
#pragma unroll
        for (int j = 0; j < 8; ++j)
#pragma unroll
            for (int t = 0; t < 2; ++t) { f32x4 s = MFMA16(fb[j * 4 + t * 2], bq0, z4); s = MFMA16(fb[j * 4 + t * 2 + 1], bq1, s); st[j][t] = s; }
        ATTN_SB();
        {
            const LAS unsigned char* v0 = cvl + fr * 512;
#pragma unroll
            for (int j = 0; j < 8; ++j) { const int xo = ((4 * j + fq) ^ fr) << 4;
#pragma unroll
                for (int dt = 0; dt < 4; ++dt) fb[j * 4 + dt] = *(const LAS bf16x8*)(v0 + dt * 8192 + xo); }
        }
        ATTN_SB();
        float m2 = NEG;
#pragma unroll
        for (int g = 0; g < 8; ++g)
#pragma unroll
            for (int t = 0; t < 2; ++t) m2 = fmaxf(m2, fmaxf(fmaxf(st[g][t][0], st[g][t][1]), fmaxf(st[g][t][2], st[g][t][3])));
        m2 = fmaxf(m2, __shfl_xor(m2, 16)); m2 = fmaxf(m2, __shfl_xor(m2, 32));
        const float mn = fmaxf(m, m2);
        const float alpha = __builtin_amdgcn_exp2f(m - mn);
        l *= alpha;
#pragma unroll
        for (int e = 0; e < 4; ++e) { const float aq = __shfl(alpha, 4 * fq + e);
#pragma unroll
            for (int dt = 0; dt < 4; ++dt) o[dt][e] *= aq; }
#pragma unroll
        for (int g = 0; g < 8; ++g)
#pragma unroll
            for (int t = 0; t < 2; ++t)
#pragma unroll
                for (int e = 0; e < 4; ++e) { const float p = __builtin_amdgcn_exp2f(st[g][t][e] - mn); st[g][t][e] = p; l += p; }
        ATTN_SB();
#pragma unroll
        for (int j = 0; j < 8; ++j) {
            u32x4 pw; pw.x = cvtpk_s(st[j][0][0], st[j][0][1]); pw.y = cvtpk_s(st[j][0][2], st[j][0][3]); pw.z = cvtpk_s(st[j][1][0], st[j][1][1]); pw.w = cvtpk_s(st[j][1][2], st[j][1][3]);
            const bf16x8 pa = __builtin_bit_cast(bf16x8, pw);
#pragma unroll
            for (int dt = 0; dt < 4; ++dt) o[dt] = MFMA16(pa, fb[j * 4 + dt], o[dt]);
        }
    }
    __builtin_amdgcn_sched_barrier(0);
    l += __shfl_xor(l, 16); l += __shfl_xor(l, 32);
    const float inv = 1.0f / l;
    asm volatile("" ::: "memory");
#pragma unroll
    for (int e = 0; e < 4; ++e) { const float il = __shfl(inv, 4 * fq + e);
#pragma unroll
        for (int dt = 0; dt < 4; ++dt) *(LAS unsigned short*)(ot + (4 * fq + e) * 128 + (dt * 16 + fr) * 2) = pg8::f2bf_rne(o[dt][e] * il); }
    asm volatile("" ::: "memory");
#pragma unroll
    for (int k = 0; k < 2; ++k) { const int p = lane + 64 * k, q = p >> 3, dc = p & 7;
        const u32x4 w = *(const LAS u32x4*)(ot + q * 128 + dc * 16);
        *(u32x4*)(OB + (size_t)(qrow0 + q) * 1024 + h * 64 + dc * 8) = w; }
    asm volatile("" ::: "memory");
}

template <int NMT> __device__ __forceinline__ void sg_unit(int chunk, int g, int cofs, const bf16_t* VST, const bf16_t* QU, bf16_t* OB, const float* stats, const float* lng, const float* lnb, const bf16_t* WSb, const float* bs, int lane_) {
    int lane = lane_; asm volatile("" : "+v"(lane));
    const int fr = lane & 15, fq = lane >> 4;
    const int R0 = chunk < 256 ? chunk * 128 : MX + (chunk - 256) * 128;
    const int ch0 = g * 128 + cofs;
    u32x4 raw[NMT][4]; pg8::f32x2 sv[4][8];
#pragma unroll
    for (int ks = 0; ks < 4; ++ks) {
#pragma unroll
        for (int j = 0; j < 8; ++j) sv[ks][j] = *(const pg8::f32x2*)(stats + 2 * (size_t)(R0 + ks * 32 + 8 * fq + j));
#pragma unroll
        for (int mt = 0; mt < NMT; ++mt) raw[mt][ks] = *(const u32x4*)(VST + ((size_t)((R0 >> 3) + ks * 4 + fq) * 512 + ch0 + mt * 16 + fr) * 8);
    }
    float lg[NMT], lb[NMT];
#pragma unroll
    for (int mt = 0; mt < NMT; ++mt) { lg[mt] = lng[ch0 + mt * 16 + fr]; lb[mt] = lnb[ch0 + mt * 16 + fr]; }
    const bf16_t* wp0 = WSb + (size_t)(g * 128 + fr) * 128 + 8 * fq;
    bf16x8 wf[2][4]; u32x2 uu[2][NMT]; float bsv[2];
#pragma unroll
    for (int ks = 0; ks < 4; ++ks) wf[0][ks] = *(const bf16x8*)(wp0 + ks * 32);
#pragma unroll
    for (int mt = 0; mt < NMT; ++mt) uu[0][mt] = *(const u32x2*)(QU + (size_t)(R0 + fr) * 1024 + 512 + ch0 + mt * 16 + 4 * fq);
    bsv[0] = bs[g * 128 + fr];
    __builtin_amdgcn_sched_barrier(0);
    bf16x8 af[NMT][4];
#pragma unroll
    for (int ks = 0; ks < 4; ++ks) {
        float mu[8], rs[8];
#pragma unroll
        for (int j = 0; j < 8; ++j) { const float mean = sv[ks][j][0] * (1.0f / 512.0f); const float var = fmaxf(sv[ks][j][1] * (1.0f / 512.0f) - mean * mean, 0.f); mu[j] = mean; rs[j] = 1.0f / sqrtf(var + EPS); }
#pragma unroll
        for (int mt = 0; mt < NMT; ++mt) {
            const u32x4 rw = raw[mt][ks];
            float v[8]; v[0] = pg8::bflo(rw.x); v[1] = pg8::bfhi(rw.x); v[2] = pg8::bflo(rw.y); v[3] = pg8::bfhi(rw.y); v[4] = pg8::bflo(rw.z); v[5] = pg8::bfhi(rw.z); v[6] = pg8::bflo(rw.w); v[7] = pg8::bfhi(rw.w);
#pragma unroll
            for (int j = 0; j < 8; ++j) v[j] = (v[j] - mu[j]) * rs[j] * lg[mt] + lb[mt];
            u32x4 pw; pw.x = cvtpk_s(v[0], v[1]); pw.y = cvtpk_s(v[2], v[3]); pw.z = cvtpk_s(v[4], v[5]); pw.w = cvtpk_s(v[6], v[7]);
            af[mt][ks] = __builtin_bit_cast(bf16x8, pw);
        }
    }
    const f32x4 z4 = {0.f, 0.f, 0.f, 0.f};
#pragma unroll
    for (int nt = 0; nt < 8; ++nt) {
        const int cur = nt & 1, nxt = cur ^ 1;
        if (nt < 7) {
#pragma unroll
            for (int ks = 0; ks < 4; ++ks) wf[nxt][ks] = *(const bf16x8*)(wp0 + (size_t)(nt + 1) * 16 * 128 + ks * 32);
#pragma unroll
            for (int mt = 0; mt < NMT; ++mt) uu[nxt][mt] = *(const u32x2*)(QU + (size_t)(R0 + (nt + 1) * 16 + fr) * 1024 + 512 + ch0 + mt * 16 + 4 * fq);
            bsv[nxt] = bs[g * 128 + (nt + 1) * 16 + fr];
        }
        f32x4 a[NMT];
#pragma unroll
        for (int mt = 0; mt < NMT; ++mt) a[mt] = z4;
#pragma unroll
        for (int ks = 0; ks < 4; ++ks)
#pragma unroll
            for (int mt = 0; mt < NMT; ++mt) a[mt] = MFMA16(af[mt][ks], wf[cur][ks], a[mt]);
        const float bv = bsv[cur];
        unsigned q[NMT][2];
#pragma unroll
        for (int mt = 0; mt < NMT; ++mt) { const u32x2 u0 = uu[cur][mt];
            q[mt][0] = cvtpk_s(pg8::bflo(u0.x) * (a[mt][0] + bv), pg8::bfhi(u0.x) * (a[mt][1] + bv)); q[mt][1] = cvtpk_s(pg8::bflo(u0.y) * (a[mt][2] + bv), pg8::bfhi(u0.y) * (a[mt][3] + bv)); }
        const size_t uo = (size_t)(R0 + nt * 16 + fr) * 1024 + 512 + ch0;
#pragma unroll
        for (int mp = 0; mp < NMT / 2; ++mp) { int co; const u32x4 w = pg8::quad_swap(q[2 * mp][0], q[2 * mp][1], q[2 * mp + 1][0], q[2 * mp + 1][1], fq, co); *(u32x4*)(OB + uo + mp * 32 + co) = w; }
    }
}

__device__ __forceinline__ void ctx_resid_gemm(const bf16_t* A  , const bf16_t* Bt  , int K, float* XC, const float* gate  , float coef, int gw, int NGW, int lane) {
    const int fr = lane & 15, fq = lane >> 4;
    for (int tile = gw; tile < 32 * 64; tile += NGW) {
        const int rt = tile >> 6, ct = tile & 63;
        const bf16_t* ap = A + (size_t)(MX + rt * 16 + fr) * K + 8 * fq; const bf16_t* bp = Bt + (size_t)(ct * 16 + fr) * K + 8 * fq;
        f32x4 acc0 = {0.f, 0.f, 0.f, 0.f}, acc1 = acc0;
#pragma unroll 4
        for (int ks = 0; ks < K; ks += 64) {
            acc0 = MFMA16(*(const bf16x8*)(ap + ks), *(const bf16x8*)(bp + ks), acc0);
            acc1 = MFMA16(*(const bf16x8*)(ap + ks + 32), *(const bf16x8*)(bp + ks + 32), acc1);
        }
        const int col = ct * 16 + fr; const float gv = gate[col] * coef;
#pragma unroll
        for (int e = 0; e < 4; ++e) { float* xp = XC + (size_t)(rt * 16 + 4 * fq + e) * D + col; *xp = *xp + gv * (acc0[e] + acc1[e]); }
    }
}

#ifndef MK_SP2
#define MK_SP2 true
#endif
#ifndef MK_ALIGN
#define MK_ALIGN true
#endif
template <class Epi> __device__ __forceinline__ void run_gemm(LAS unsigned char* lds, const bf16_t* A, const bf16_t* Bt, int M, int N, int K, const Epi& E) {
    pg8::Gemm g{A, Bt, M, N, K}; pg8::StaticOrder S; S.init(M, N, (int)gridDim.x, (int)blockIdx.x);
    pg8::gemm_phase<Epi, pg8::StaticOrder, MK_ALIGN, MK_SP2>(lds, g, S, E);
}


__device__ __forceinline__ kptr_t kargs() { kptr_t p = (kptr_t)__builtin_amdgcn_kernarg_segment_ptr(); asm volatile("" : "+s"(p)); return p; }
#define KIN(i) KPTR(const float, i)
#define KOUT() KPTR(float, 22)
#define KWS() KPTR(unsigned char, 23)
#define PH_BEGIN() const kptr_t kp = kargs(); unsigned char* const ws = KWS(); (void)ws; int tid_ = threadIdx.x; asm volatile("" : "+v"(tid_)); const int lane = tid_ & 63, wave = __builtin_amdgcn_readfirstlane(tid_ >> 6); \
    const int gw = blockIdx.x * NWAVES + wave, NGW = gridDim.x * NWAVES; (void)lane; (void)gw; (void)NGW

#define RLX_AGENT __ATOMIC_RELAXED, __HIP_MEMORY_SCOPE_AGENT
#define XB_TMO      128
#define XB_XCNT(j)  (256  + 64 * (j))
#define XB_XSUB(j)  (1280 + 64 * (j))
#define XB_XGEN(j)  (2304 + 64 * (j))
#define XB_TOP      3328
#define XB_TOPGEN   3392
#define XCD_BAR_WORDS 3456
#define XB_SPIN_CAP (1u << 18)

__device__ __forceinline__ unsigned xb_ld(unsigned* p)              { return __hip_atomic_load(p, __ATOMIC_RELAXED, __HIP_MEMORY_SCOPE_AGENT); }
__device__ __forceinline__ unsigned xb_add(unsigned* p, unsigned v) { return __hip_atomic_fetch_add(p, v, __ATOMIC_RELAXED, __HIP_MEMORY_SCOPE_AGENT); }
__device__ __forceinline__ unsigned xb_xcc_id() { return (unsigned)__builtin_amdgcn_s_getreg((3 << 11) | 20) & 0xFu; }
#define XB_SPIN(cond, bar) do { unsigned _sp = 0; while (cond) { __builtin_amdgcn_s_sleep(1); \
    if ((++_sp & 255u) == 0u) { if (xb_ld(&(bar)[XB_TMO])) break; if (_sp > XB_SPIN_CAP) { atomicAdd(&(bar)[XB_TMO], 1u); break; } } } } while (0)

struct XcdBarrier {
    unsigned* bar; unsigned x;
    volatile LAS unsigned* st;
};

__device__ __forceinline__ XcdBarrier xcd_barrier_post(unsigned* bar, volatile LAS unsigned* st) {
    XcdBarrier b; b.bar = bar; b.x = xb_xcc_id(); b.st = st;
    if (threadIdx.x == 0) (void)xb_add(&bar[XB_XCNT(b.x)], 1u);
    return b;
}
__device__ __forceinline__ void xcd_barrier_complete(unsigned* bar, unsigned x, unsigned& nloc, unsigned& nx) {
    const unsigned G = gridDim.x * gridDim.y * gridDim.z;
    unsigned sum, cnt, mine, sp = 0u;
    for (;;) {
        sum = 0u; cnt = 0u; mine = 0u;
#pragma unroll
        for (unsigned j = 0; j < 16; ++j) { const unsigned c = xb_ld(&bar[XB_XCNT(j)]); sum += c; cnt += (c > 0u) ? 1u : 0u; mine = (j == x) ? c : mine; }
        if (sum == G) break;
        __builtin_amdgcn_s_sleep(1);
        if ((++sp & 255u) == 0u) { if (xb_ld(&bar[XB_TMO])) break; if (sp > XB_SPIN_CAP) { atomicAdd(&bar[XB_TMO], 1u); break; } }
    }
    nloc = mine > 0u ? mine : 1u; nx = cnt > 0u ? cnt : 1u;
}

__device__ __forceinline__ void xcd_barrier(const XcdBarrier& b) {
    asm volatile("s_waitcnt vmcnt(0)" ::: "memory");
    __syncthreads();
    if (threadIdx.x == 0) {
        unsigned* bar = b.bar;
        __builtin_amdgcn_s_waitcnt(0);
        unsigned nloc = b.st[0], nx = b.st[1];
        if (nloc == 0u) { xcd_barrier_complete(bar, b.x, nloc, nx); b.st[0] = nloc; b.st[1] = nx; }
        const unsigned old = xb_add(&bar[XB_XSUB(b.x)], 1u);
        const unsigned gen = old / nloc;
        if (old + 1u == (gen + 1u) * nloc) {
            __builtin_amdgcn_fence(__ATOMIC_RELEASE, "agent");
            asm volatile("s_waitcnt vmcnt(0)" ::: "memory");
            const unsigned og = xb_add(&bar[XB_TOP], 1u);
            const unsigned tg = og / nx;
            if (og + 1u == (tg + 1u) * nx) xb_add(&bar[XB_TOPGEN], 1u);
            else XB_SPIN(xb_ld(&bar[XB_TOPGEN]) == tg, bar);
            __builtin_amdgcn_fence(__ATOMIC_ACQUIRE, "agent");
            xb_add(&bar[XB_XGEN(b.x)], 1u);
            asm volatile("s_waitcnt vmcnt(0)" ::: "memory");
        } else {
            XB_SPIN(xb_ld(&bar[XB_XGEN(b.x)]) == gen, bar);
            __builtin_amdgcn_fence(__ATOMIC_ACQUIRE, "agent");
            asm volatile("s_waitcnt vmcnt(0)" ::: "memory");
        }
    }
    __syncthreads();
}


__device__ __forceinline__ void gbar(int k, int word = 0) {
    asm volatile("s_waitcnt vmcnt(0)" ::: "memory");
    __syncthreads();
    if (threadIdx.x == 0) {
        const kptr_t kp = kargs(); unsigned* cnt = (unsigned*)(KPTR(unsigned char, 23) + CTL_BAR) + word;
        __builtin_amdgcn_fence(__ATOMIC_RELEASE, "agent");
        asm volatile("s_waitcnt vmcnt(0)" ::: "memory");
        (void)__hip_atomic_fetch_add(cnt, 1u, __ATOMIC_RELAXED, __HIP_MEMORY_SCOPE_AGENT);
        const unsigned target = (unsigned)(k + 1) * gridDim.x;
        unsigned sp = 0u;
        while (__hip_atomic_load(cnt, __ATOMIC_RELAXED, __HIP_MEMORY_SCOPE_AGENT) < target) { __builtin_amdgcn_s_sleep(1); if (++sp > (1u << 24)) break; }
        __builtin_amdgcn_fence(__ATOMIC_ACQUIRE, "agent");
        asm volatile("s_waitcnt vmcnt(0)" ::: "memory");
    }
    __syncthreads();
}
#ifdef PROBE_SYNC
#define GSYNC(j) do { gbar(2 * (L * 11 + (j))); gbar(2 * (L * 11 + (j)) + 1); } while (0)
#else
__device__ __forceinline__ void xbar(LAS unsigned char* lds) {
    const kptr_t kp = kargs(); XcdBarrier b; b.bar = (unsigned*)(KPTR(unsigned char, 23) + CTL_XBAR); b.x = xb_xcc_id(); b.st = (volatile LAS unsigned*)(lds + LDS_BARST);
    xcd_barrier(b);
}
#define GSYNC(j) xbar(lds)
#endif
template <int L> __device__ __forceinline__ void layer_fwd(cg::grid_group& grid, LAS unsigned char* lds) {
    constexpr int Mr = (L == 0) ? MALL : MX;
    constexpr size_t WL = WS_W + (size_t)L * W_LAYER, MODL = CTL_MOD + (size_t)L * 3 * 9216 * 4, STL = CTL_STATS + (size_t)L * MALL * 2 * 4;
    { PH_BEGIN(); modpass(L == 0 ? KIN(0) : KOUT(), (const float*)(ws + WS_XC), (const float*)(ws + MODL), KIN(6) + (size_t)(L * 3 + 0) * D, 0, (bf16_t*)(ws + WS_H), MALL, gw, NGW, lane); }
    GSYNC(0);
    { PH_BEGIN(); run_gemm(lds, (const bf16_t*)(ws + WS_H), (const bf16_t*)(ws + WL + W_UP1), MALL, 2 * DFF, D, pg8::EpiSwiGLU{(bf16_t*)(ws + WS_G)}); }
    GSYNC(1);
    { PH_BEGIN(); run_gemm(lds, (const bf16_t*)(ws + WS_G), (const bf16_t*)(ws + WL + W_DN1), MX, D, DFF,
                           pg8::EpiResid{L == 0 ? KIN(0) : KOUT(), (const float*)(ws + WS_XC), KOUT(), (float*)(ws + WS_XC), (const float*)(ws + MODL) + 2 * 1024, 0.5f}); }
    { PH_BEGIN(); ctx_resid_gemm((const bf16_t*)(ws + WS_G), (const bf16_t*)(ws + WL + W_DN1), DFF, (float*)(ws + WS_XC), (const float*)(ws + MODL) + 2 * 9216 + 2 * 1024, 0.5f, gw, NGW, lane); }
    GSYNC(2);
    { PH_BEGIN(); modpass(KOUT(), (const float*)(ws + WS_XC), (const float*)(ws + MODL), KIN(6) + (size_t)(L * 3 + 1) * D, 1, (bf16_t*)(ws + WS_H), MALL, gw, NGW, lane); }
    GSYNC(3);
    { PH_BEGIN(); run_gemm(lds, (const bf16_t*)(ws + WS_H), (const bf16_t*)(ws + WL + W_IN), MALL, INC, D,
                           pg8::EpiWin{(bf16_t*)(ws + WS_QU), (bf16_t*)(ws + WS_KB), (bf16_t*)(ws + WS_VT), (bf16_t*)(ws + WS_VST), (bf16_t*)(ws + WS_GT), KIN(10) + (size_t)L * 2048,
                                       (const f32x4*)(ws + CTL_ROPE), (const f32x4*)(ws + CTL_ROPE) + 256 * 8, (float*)(ws + STL), QSCALE, lds + 131072}); }
    GSYNC(4);
#ifdef PROBE_ATTN
    constexpr int NREP_ATTN = 2;
#else
    constexpr int NREP_ATTN = 1;
#endif
#pragma unroll 1
    for (int rep = 0; rep < NREP_ATTN; ++rep) { PH_BEGIN();
        if (rep > 0) gbar(L, 64);
        unsigned* cnt_attn = (unsigned*)(ws + CTL_CNT) + 64 * (2 * L) + 256 * rep;
        { const float* rg = KIN(11) + (size_t)L * 8 * 465; for (int i = threadIdx.x; i < 8 * 465; i += NTHREADS) ((LAS float*)(lds + LDS_RPB))[i] = rg[i] * LOG2E; }
        __syncthreads();
        const bf16_t* KBp = (const bf16_t*)(ws + WS_KB); const bf16_t* VTp = (const bf16_t*)(ws + WS_VT); const bf16_t* QUp = (const bf16_t*)(ws + WS_QU); bf16_t* OBp = (bf16_t*)(ws + WS_H);
        const LAS float* rpbl = (const LAS float*)(lds + LDS_RPB); LAS unsigned char* otl = lds + LDS_OT + wave * 2048;
        const int lw = (blockIdx.x >> 3) * 8 + wave, xcd = blockIdx.x & 7, hp = (blockIdx.x >> 3) & 3;
#pragma unroll 1
        for (int s = 0; s < 10; ++s) {
            const int bb = s / 5, k = s - 5 * bb;
            int u, hs;
            if (k == 0) {
                __syncthreads();
                const int h0 = hp * 2; int tid = threadIdx.x; asm volatile("" : "+v"(tid));
#pragma unroll
                for (int i = 0; i < 8; ++i) { const int ca = tid + 512 * i, hq = ca >> 11, ci = ca & 2047, key = ci >> 3, c = ci & 7;
                    const u32x4 v = *(const u32x4*)(KBp + ((size_t)(h0 + hq) * MALL + (MX + bb * 256 + key)) * 64 + c * 8);
                    *(LAS u32x4*)(lds + LDS_CK + hq * 32768 + key * 128 + ((c ^ ((((key >> 3) & 3) * 2) + ((key >> 1) & 1))) << 4)) = v; }
#pragma unroll
                for (int i = 0; i < 8; ++i) { const int ca = tid + 512 * i, hq = ca >> 11, ci = ca & 2047, blk = ci >> 6, d = ci & 63;
                    const u32x4 v = *(const u32x4*)(VTp + ((size_t)(((MX + bb * 256) >> 3) + blk) * 512 + (h0 + hq) * 64 + d) * 8);
                    *(LAS u32x4*)(lds + LDS_CV + hq * 32768 + d * 512 + ((blk ^ (d & 15)) << 4)) = v; }
                __syncthreads();
            }
            if (k < 4) { const int pair = (bb * 4 + k) * 8 + (lw >> 5), rr = 32 * xcd + (pair & 31); u = (bb << 13) | (rr << 5) | (lw & 31); hs = wave >> 2; }
            else {
                if (L != 0 || xcd >= 4 || wave != 0) continue;
                const int idx = xcd * 8 + (blockIdx.x >> 5); hs = idx >> 4;
                u = 16384 + (bb << 7) + (((idx >> 2) & 3) << 5) + ((hp * 2 + hs) << 2) + (idx & 3);
            }
            attn_unit(u, KBp, VTp, QUp, OBp, rpbl, otl, lds + LDS_CK + hs * 32768, lds + LDS_CV + hs * 32768, lane);
        }
    }
    { PH_BEGIN();
        unsigned* cnt_sg = (unsigned*)(ws + CTL_CNT) + 64 * (2 * L + 1);
        const bf16_t* VSTp = (const bf16_t*)(ws + WS_VST); const bf16_t* QUp = (const bf16_t*)(ws + WS_QU); bf16_t* OBp = (bf16_t*)(ws + WS_H); const float* stp = (const float*)(ws + STL); const bf16_t* wsb = (const bf16_t*)(ws + WL + W_S);
        for (int u = gw; u < 2048; u += NGW) sg_unit<4>(u >> 3, (u >> 1) & 3, (u & 1) * 64, VSTp, QUp, OBp, stp, KIN(12) + L * 512, KIN(13) + L * 512, wsb, KIN(15) + L * 512, lane);
        if (L == 0)
            for (;;) { const int u = wq_next(cnt_sg, lane); if (u >= 64) break; sg_unit<2>(256 + (u >> 4), (u >> 2) & 3, (u & 3) * 32, VSTp, QUp, OBp, stp, KIN(12) + L * 512, KIN(13) + L * 512, wsb, KIN(15) + L * 512, lane); }
    }
    GSYNC(5);
    { PH_BEGIN(); run_gemm(lds, (const bf16_t*)(ws + WS_H), (const bf16_t*)(ws + WL + W_PAB), Mr, 2048, D, pg8::EpiMerge{(const bf16_t*)(ws + WS_GT), (bf16_t*)(ws + WS_MRG)}); }
    GSYNC(6);
    { PH_BEGIN(); run_gemm(lds, (const bf16_t*)(ws + WS_MRG), (const bf16_t*)(ws + WL + W_O), MX, D, D,
                           pg8::EpiResid{KOUT(), (const float*)(ws + WS_XC), KOUT(), (float*)(ws + WS_XC), (const float*)(ws + MODL) + 5 * 1024, 1.0f}); }
    if (L == 0) { PH_BEGIN(); ctx_resid_gemm((const bf16_t*)(ws + WS_MRG), (const bf16_t*)(ws + WL + W_O), D, (float*)(ws + WS_XC), (const float*)(ws + MODL) + 2 * 9216 + 5 * 1024, 1.0f, gw, NGW, lane); }
    GSYNC(7);
    { PH_BEGIN(); modpass(KOUT(), (const float*)(ws + WS_XC), (const float*)(ws + MODL), KIN(6) + (size_t)(L * 3 + 2) * D, 2, (bf16_t*)(ws + WS_H), Mr, gw, NGW, lane); }
    GSYNC(8);
    { PH_BEGIN(); run_gemm(lds, (const bf16_t*)(ws + WS_H), (const bf16_t*)(ws + WL + W_UP2), Mr, 2 * DFF, D, pg8::EpiSwiGLU{(bf16_t*)(ws + WS_G)}); }
    GSYNC(9);
    { PH_BEGIN(); run_gemm(lds, (const bf16_t*)(ws + WS_G), (const bf16_t*)(ws + WL + W_DN2), MX, D, DFF,
                           pg8::EpiResid{KOUT(), (const float*)(ws + WS_XC), KOUT(), (float*)(ws + WS_XC), (const float*)(ws + MODL) + 8 * 1024, 0.5f}); }
    if (L == 0) { PH_BEGIN(); ctx_resid_gemm((const bf16_t*)(ws + WS_G), (const bf16_t*)(ws + WL + W_DN2), DFF, (float*)(ws + WS_XC), (const float*)(ws + MODL) + 2 * 9216 + 8 * 1024, 0.5f, gw, NGW, lane); }
    GSYNC(10);
}

__global__ void __launch_bounds__(NTHREADS, 2) mega_fwd(Args a) {
    extern __shared__ __attribute__((aligned(16))) unsigned char lds_raw[];
    cg::grid_group grid = cg::this_grid();
    LAS unsigned char* lds = (LAS unsigned char*)lds_raw;
    if (threadIdx.x < 2) ((volatile LAS unsigned*)(lds + LDS_BARST))[threadIdx.x] = 0u;
    __syncthreads();
    { const kptr_t kp = kargs(); (void)xcd_barrier_post((unsigned*)(KPTR(unsigned char, 23) + CTL_XBAR), (volatile LAS unsigned*)(lds + LDS_BARST)); }
    { PH_BEGIN(); prologue(kp, (LAS float*)(lds + wave * 16384), gw, NGW, lane); }
    if (gridDim.y == 0x7fffffffu) grid.sync();
    xbar(lds);
    layer_fwd<0>(grid, lds);
    layer_fwd<1>(grid, lds);
    { PH_BEGIN(); final_norm(KOUT(), KIN(21), gw, NGW, lane); }
}

extern "C" void kernel_launch(void* const* d_in, const int* in_sizes, int n_in, void* d_out, int out_size, void* d_ws, size_t ws_size, hipStream_t stream) {
    static int grid = 0;
    if (grid == 0) {
        if (n_in != 22 || out_size != MX * D || ws_size < WS_END) { fprintf(stderr, "kernel_launch: unexpected problem (n_in %d, out %d, ws %zu)\n", n_in, out_size, ws_size); grid = -1; return; }
        int dev = 0, cus = 0, per_cu = 0;
        hipGetDevice(&dev); hipDeviceGetAttribute(&cus, hipDeviceAttributeMultiprocessorCount, dev);
        if (hipFuncSetAttribute((const void*)mega_fwd, hipFuncAttributeMaxDynamicSharedMemorySize, LDS_BYTES) != hipSuccess) { fprintf(stderr, "kernel_launch: hipFuncSetAttribute failed\n"); grid = -1; return; }
        if (hipOccupancyMaxActiveBlocksPerMultiprocessor(&per_cu, (const void*)mega_fwd, NTHREADS, LDS_BYTES) != hipSuccess || per_cu < 1) { fprintf(stderr, "kernel_launch: occupancy query gave %d\n", per_cu); per_cu = 1; }
        (void)hipGetLastError();
        grid = cus * per_cu;
        if (grid != 256) { fprintf(stderr, "kernel_launch: this kernel is built for exactly 256 co-resident workgroups (256 CUs x 1), got %d; nothing launched\n", grid); grid = -1; return; }
        fprintf(stderr, "kernel_launch: grid %d (cus %d x %d)\n", grid, cus, per_cu);
    }
    if (grid < 0) return;
    hipMemsetAsync((char*)d_ws, 0, CTL_BYTES, stream);
    Args a{};
    for (int i = 0; i < 22; ++i) a.in[i] = (const float*)d_in[i];
    a.out = (float*)d_out; a.ws = (unsigned char*)d_ws;
    void* args[] = {&a};
    hipError_t e = hipLaunchCooperativeKernel((const void*)mega_fwd, dim3(grid), dim3(NTHREADS), args, LDS_BYTES, stream);
    if (e != hipSuccess) fprintf(stderr, "cooperative launch failed: %s (grid %d)\n", hipGetErrorString(e), grid);
}
```

```cpp
#include <hip/hip_runtime.h>
#include <hip/hip_cooperative_groups.h>
#include <cstdio>
#include <cstdint>
#include <cmath>
namespace pg8 {
#define PG8_LAS __attribute__((address_space(3)))
typedef unsigned short bf16_t;
typedef short bf16x8 __attribute__((ext_vector_type(8)));
typedef float f32x4 __attribute__((ext_vector_type(4)));
typedef unsigned u32x4 __attribute__((ext_vector_type(4)));
constexpr int BM = 256, BK = 64, HALF = 128, HTB = HALF * BK * 2  , STAGE_BYTES = 8 * HTB, NXCD = 8, WGM = 8;

__host__ __device__ __forceinline__ int lds_byte(int r, int c) { const int st = (r >> 4) * 2 + (c >> 5), rr = r & 15, cc = c & 31, ob = rr * 64 + cc * 2; return st * 1024 + (ob ^ (((ob >> 9) & 1) << 5)); }
__host__ __device__ __forceinline__ void stage_rc(int b, int& R, int& C) { const int st = b / 1024, sb = b % 1024, swz = sb ^ (((sb >> 9) & 1) << 5); R = (st >> 1) * 16 + swz / 64; C = (st & 1) * 32 + (swz % 64) / 2; }
__host__ __device__ __forceinline__ int perm32(int rho) { const int n = rho >> 4, i = rho & 15; return 8 * (i >> 2) + 4 * n + (i & 3); }

struct Unit { int pm, pn; };
struct Gemm { const bf16_t* A; const bf16_t* Bt; int M, N, K; };

struct StaticOrder {
    int nM, nN, nwg, G, c;
    __host__ __device__ void init(int M, int N, int G_, int c_) { nM = M / BM; nN = N / BM; nwg = nM * nN; G = G_; c = c_; }
    __host__ __device__ bool next(int i, Unit& u) const {
        const long L = (long)i * G + c; if (L >= nwg) return false;
        int wgid = (int)L; { const int q = nwg / NXCD, r = nwg % NXCD, xcd = wgid % NXCD, off = wgid / NXCD; wgid = (xcd < r ? xcd * (q + 1) : r * (q + 1) + (xcd - r) * q) + off; }
        const int nig = WGM * nN, gid = wgid / nig, fm = gid * WGM, gsz = (nM - fm) < WGM ? (nM - fm) : WGM;
        u.pm = fm + ((wgid % nig) % gsz); u.pn = (wgid % nig) / gsz; return true;
    }
    __device__ __forceinline__ void a_ready(const Unit&) const {}
    __device__ __forceinline__ void done(const Unit&) const {}
};

__device__ __forceinline__ unsigned cvt_pk_bf16(float lo, float hi) { unsigned r; asm volatile("v_cvt_pk_bf16_f32 %0, %1, %2" : "=v"(r) : "v"(lo), "v"(hi)); return r; }
constexpr int D_ = 1024, MX_ = 32768, MALL_ = 33280, DFF_ = 2816;
typedef float f32x2 __attribute__((ext_vector_type(2)));
__device__ __forceinline__ float fast_sigmoid(float x) { return __builtin_amdgcn_rcpf(1.0f + __builtin_amdgcn_exp2f(-1.4426950408889634f * x)); }
__device__ __forceinline__ float silu_f(float x) { return x * fast_sigmoid(x); }
__device__ __forceinline__ float gelu_tanh(float x) { const float u = 1.5957691216057308f * (x + 0.044715f * x * x * x); return x * fast_sigmoid(u); }
__device__ __forceinline__ float bf2f(unsigned short b) { return __uint_as_float(((unsigned)b) << 16); }
__device__ __forceinline__ float bflo(unsigned w) { return __uint_as_float(w << 16); }
__device__ __forceinline__ float bfhi(unsigned w) { return __uint_as_float(w & 0xffff0000u); }
__device__ __forceinline__ unsigned short f2bf_rne(float f) { unsigned u = __float_as_uint(f); return (unsigned short)((u + 0x7fffu + ((u >> 16) & 1u)) >> 16); }

__device__ __forceinline__ u32x4 quad_swap(unsigned lo0, unsigned lo1, unsigned hi0, unsigned hi1, int fq, int& coloff) {
    const bool odd = fq & 1;
    const unsigned s0 = odd ? lo0 : hi0, s1 = odd ? lo1 : hi1;
    const unsigned r0 = (unsigned)__shfl_xor((int)s0, 16), r1 = (unsigned)__shfl_xor((int)s1, 16);
    coloff = odd ? 16 + 4 * (fq - 1) : 4 * fq;
    u32x4 o; o.x = odd ? r0 : lo0; o.y = odd ? r1 : lo1; o.z = odd ? hi0 : r0; o.w = odd ? hi1 : r1; return o;
}

struct EpiSwiGLU {
    static constexpr bool PERM = true, AFTER_DRAIN = false;
    bf16_t* O;
    __device__ __forceinline__ void operator()(const f32x4 (&acc)[2][2][4][2], const Unit& u, int wr, int wc, int fr, int fq) const {
        const int row0 = u.pm * BM + wr * 64 + fr, col0 = u.pn * HALF + wc * 32 + 8 * fq;
#pragma unroll
        for (int ai = 0; ai < 2; ++ai)
#pragma unroll
            for (int m = 0; m < 4; ++m) {
                bf16_t* p = O + (size_t)(row0 + ai * HALF + m * 16) * DFF_ + col0;
                const f32x4 a0 = acc[ai][0][m][0], a1 = acc[ai][0][m][1], b0 = acc[ai][1][m][0], b1 = acc[ai][1][m][1];
                float h[8];
#pragma unroll
                for (int e = 0; e < 4; ++e) { h[e] = silu_f(a0[e]) * b0[e]; h[4 + e] = silu_f(a1[e]) * b1[e]; }
                u32x4 w; w.x = cvt_pk_bf16(h[0], h[1]); w.y = cvt_pk_bf16(h[2], h[3]); w.z = cvt_pk_bf16(h[4], h[5]); w.w = cvt_pk_bf16(h[6], h[7]);
                *(u32x4*)p = w;
            }
    }
};

struct EpiResid {
    static constexpr bool PERM = false, AFTER_DRAIN = false;
    const float* src_main; const float* src_ctx; float* dst_main; float* dst_ctx; const float* gate_l  ; float coef;
    __device__ __forceinline__ void operator()(const f32x4 (&acc)[2][2][4][2], const Unit& u, int wr, int wc, int fr, int fq) const {
        const int cond = u.pm < 64 ? 0 : (u.pm < 128 ? 1 : 2);
        const float* gate = gate_l + cond * 9216;
        const int col0 = u.pn * BM + wc * 32 + 4 * fq;
        f32x4 gv[2][2];
#pragma unroll
        for (int bj = 0; bj < 2; ++bj)
#pragma unroll
            for (int n = 0; n < 2; ++n) gv[bj][n] = *(const f32x4*)(gate + col0 + bj * HALF + n * 16) * coef;
#pragma unroll
        for (int ai = 0; ai < 2; ++ai)
#pragma unroll
            for (int m = 0; m < 4; ++m) {
                const int row = u.pm * BM + ai * HALF + wr * 64 + m * 16 + fr;
                const float* s = row < MX_ ? src_main + (size_t)row * D_ : src_ctx + (size_t)(row - MX_) * D_;
                float* d = row < MX_ ? dst_main + (size_t)row * D_ : dst_ctx + (size_t)(row - MX_) * D_;
#pragma unroll
                for (int bj = 0; bj < 2; ++bj)
#pragma unroll
                    for (int n = 0; n < 2; ++n) { const int off = col0 + bj * HALF + n * 16; const f32x4 xo = *(const f32x4*)(s + off); *(f32x4*)(d + off) = xo + gv[bj][n] * acc[ai][bj][m][n]; }
            }
    }
};

struct EpiWin {
    static constexpr bool PERM = true, AFTER_DRAIN = false;
    bf16_t *QU, *KB, *VT, *VST, *GT; const float* bgate; const f32x4* ropeR; const f32x4* ropeC; float* stats; float qscale; PG8_LAS unsigned char* tl  ;
    __device__ __forceinline__ void operator()(const f32x4 (&acc)[2][2][4][2], const Unit& u, int wr, int wc, int fr, int fq) const {
        const int pn = u.pn, rowbase = u.pm * BM + wr * 64 + fr, cl = wc * 32 + 8 * fq;
        if (pn < 4) {
            const bool isq = pn < 2; bf16_t* O = isq ? QU : KB; const int ldo = isq ? 1024 : 512; const int cb = (pn & 1) * 256;
            const bool dorope = u.pm < 128; const float sc = isq ? qscale : 1.0f;
#pragma unroll
            for (int ai = 0; ai < 2; ++ai)
#pragma unroll
                for (int m = 0; m < 4; ++m) {
                    const int row = rowbase + ai * HALF + m * 16; const int t = row & 16383; const int pos = (wc & 1) ? (t & 63) : (t >> 6);
                    const f32x4* tab = ((wc & 1) ? ropeC : ropeR) + pos * 8 + 2 * fq;
                    f32x4 cs0 = (f32x4){1.f, 0.f, 1.f, 0.f}, cs1 = cs0;
                    if (dorope) { cs0 = tab[0]; cs1 = tab[1]; }
#pragma unroll
                    for (int bj = 0; bj < 2; ++bj) {
                        const f32x4 v0 = acc[ai][bj][m][0], v1 = acc[ai][bj][m][1];
                        float o[8];
                        o[0] = v0[0] * cs0[0] - v0[1] * cs0[1]; o[1] = v0[0] * cs0[1] + v0[1] * cs0[0];
                        o[2] = v0[2] * cs0[2] - v0[3] * cs0[3]; o[3] = v0[2] * cs0[3] + v0[3] * cs0[2];
                        o[4] = v1[0] * cs1[0] - v1[1] * cs1[1]; o[5] = v1[0] * cs1[1] + v1[1] * cs1[0];
                        o[6] = v1[2] * cs1[2] - v1[3] * cs1[3]; o[7] = v1[2] * cs1[3] + v1[3] * cs1[2];
                        u32x4 w; w.x = cvt_pk_bf16(o[0] * sc, o[1] * sc); w.y = cvt_pk_bf16(o[2] * sc, o[3] * sc); w.z = cvt_pk_bf16(o[4] * sc, o[5] * sc); w.w = cvt_pk_bf16(o[6] * sc, o[7] * sc);
                        const int cq = cb + bj * HALF + cl;
                        if (isq) *(u32x4*)(O + (size_t)row * 1024 + cq) = w;
                        else *(u32x4*)(O + ((size_t)(cq >> 6) * MALL_ + row) * 64 + (cq & 63)) = w;
                    }
                }
        } else if (pn < 6 || pn == 8 || pn == 9) {
            const bool isv = pn < 6; bf16_t* O = isv ? VT : VST; const int cb = (pn & 1) * 256;
            PG8_LAS unsigned char* T = tl + (wr * 4 + wc) * 2048;
            const int lane = fq * 16 + fr;
#pragma unroll
            for (int ai = 0; ai < 2; ++ai)
#pragma unroll
                for (int m = 0; m < 4; ++m) {
                    const int row = rowbase + ai * HALF + m * 16; float s1 = 0.f, s2 = 0.f;
#pragma unroll
                    for (int bj = 0; bj < 2; ++bj)
#pragma unroll
                        for (int n = 0; n < 2; ++n)
#pragma unroll
                            for (int e = 0; e < 4; ++e) {
                                float v = acc[ai][bj][m][n][e]; if (!isv) v = gelu_tanh(v);
                                const unsigned short b = f2bf_rne(v); const float vr = bf2f(b); s1 += vr; s2 += vr * vr;
                                *(PG8_LAS unsigned short*)(T + (bj * 32 + fq * 8 + n * 4 + e) * 32 + fr * 2) = b;
                            }
                    const int row16 = row - fr;
                    asm volatile("" ::: "memory");
#pragma unroll
                    for (int k = 0; k < 2; ++k) {
                        const int p = lane + 64 * k, cidx = p >> 1, half = p & 1;
                        const u32x4 w = *(const PG8_LAS u32x4*)(T + cidx * 32 + half * 16);
                        *(u32x4*)(O + ((size_t)((row16 >> 3) + half) * 512 + (cb + 128 * (cidx >> 5) + 32 * wc + (cidx & 31))) * 8) = w;
                    }
                    asm volatile("" ::: "memory");
                    if (!isv) {
                        s1 += __shfl_xor(s1, 16); s1 += __shfl_xor(s1, 32); s2 += __shfl_xor(s2, 16); s2 += __shfl_xor(s2, 32);
                        if (fq == 0) { unsafeAtomicAdd(stats + 2 * row, s1); unsafeAtomicAdd(stats + 2 * row + 1, s2); }
                    }
                }
        } else if (pn < 8) {
            const int cb = 512 + (pn - 6) * 256;
#pragma unroll
            for (int ai = 0; ai < 2; ++ai)
#pragma unroll
                for (int m = 0; m < 4; ++m) {
                    const int row = rowbase + ai * HALF + m * 16;
#pragma unroll
                    for (int bj = 0; bj < 2; ++bj) {
                        const f32x4 v0 = acc[ai][bj][m][0], v1 = acc[ai][bj][m][1];
                        u32x4 w; w.x = cvt_pk_bf16(gelu_tanh(v0[0]), gelu_tanh(v0[1])); w.y = cvt_pk_bf16(gelu_tanh(v0[2]), gelu_tanh(v0[3]));
                        w.z = cvt_pk_bf16(gelu_tanh(v1[0]), gelu_tanh(v1[1])); w.w = cvt_pk_bf16(gelu_tanh(v1[2]), gelu_tanh(v1[3]));
                        *(u32x4*)(QU + (size_t)row * 1024 + cb + bj * HALF + cl) = w;
                    }
                }
        } else {
            const int cb = (pn - 10) * 256;
            f32x4 bg[2][2];
#pragma unroll
            for (int bj = 0; bj < 2; ++bj)
#pragma unroll
                for (int n = 0; n < 2; ++n) bg[bj][n] = *(const f32x4*)(bgate + cb + bj * HALF + cl + 4 * n);
#pragma unroll
            for (int ai = 0; ai < 2; ++ai)
#pragma unroll
                for (int m = 0; m < 4; ++m) {
                    const int row = rowbase + ai * HALF + m * 16;
#pragma unroll
                    for (int bj = 0; bj < 2; ++bj) {
                        const f32x4 v0 = acc[ai][bj][m][0] + bg[bj][0], v1 = acc[ai][bj][m][1] + bg[bj][1];
                        u32x4 w; w.x = cvt_pk_bf16(fast_sigmoid(v0[0]), fast_sigmoid(v0[1])); w.y = cvt_pk_bf16(fast_sigmoid(v0[2]), fast_sigmoid(v0[3]));
                        w.z = cvt_pk_bf16(fast_sigmoid(v1[0]), fast_sigmoid(v1[1])); w.w = cvt_pk_bf16(fast_sigmoid(v1[2]), fast_sigmoid(v1[3]));
                        *(u32x4*)(GT + (size_t)row * 2048 + cb + bj * HALF + cl) = w;
                    }
                }
        }
    }
};

struct EpiMerge {
    static constexpr bool PERM = true, AFTER_DRAIN = false;
    const bf16_t* GT; bf16_t* MRG;
    __device__ __forceinline__ void operator()(const f32x4 (&acc)[2][2][4][2], const Unit& u, int wr, int wc, int fr, int fq) const {
        const int row0 = u.pm * BM + wr * 64 + fr, col0 = u.pn * HALF + wc * 32 + 8 * fq;
#pragma unroll
        for (int ai = 0; ai < 2; ++ai)
#pragma unroll
            for (int m = 0; m < 4; ++m) {
                const int row = row0 + ai * HALF + m * 16;
                const u32x4 ga = *(const u32x4*)(GT + (size_t)row * 2048 + col0), gb = *(const u32x4*)(GT + (size_t)row * 2048 + 1024 + col0);
                const f32x4 a0 = acc[ai][0][m][0], a1 = acc[ai][0][m][1], b0 = acc[ai][1][m][0], b1 = acc[ai][1][m][1];
                u32x4 w;
                w.x = cvt_pk_bf16(bflo(ga.x) * a0[0] + bflo(gb.x) * b0[0], bfhi(ga.x) * a0[1] + bfhi(gb.x) * b0[1]);
                w.y = cvt_pk_bf16(bflo(ga.y) * a0[2] + bflo(gb.y) * b0[2], bfhi(ga.y) * a0[3] + bfhi(gb.y) * b0[3]);
                w.z = cvt_pk_bf16(bflo(ga.z) * a1[0] + bflo(gb.z) * b1[0], bfhi(ga.z) * a1[1] + bfhi(gb.z) * b1[1]);
                w.w = cvt_pk_bf16(bflo(ga.w) * a1[2] + bflo(gb.w) * b1[2], bfhi(ga.w) * a1[3] + bfhi(gb.w) * b1[3]);
                *(u32x4*)(MRG + (size_t)row * 1024 + col0) = w;
            }
    }
};

template <class Epi, class Sched, bool ALIGN_EPI = false, bool SP2 = false>
__device__ __forceinline__ void gemm_phase(PG8_LAS unsigned char* lds, const Gemm g, const Sched& S, const Epi& E) {
    int tid_ = threadIdx.x; asm volatile("" : "+v"(tid_));
    const int tid = tid_, wid = __builtin_amdgcn_readfirstlane(tid >> 6), lane = tid & 63, wr = wid >> 2, wc = wid & 3, fr = lane & 15, fq = lane >> 4;
    const int K = g.K, nt = K / BK;
    unsigned voffA[2], voffB[2];
#pragma unroll
    for (int i = 0; i < 2; ++i) { int R, C; stage_rc(tid * 16 + i * 8192, R, C); const int Rb = Epi::PERM ? ((R & ~31) + perm32(R & 31)) : R;
        voffA[i] = (unsigned)(R * K + C) * 2u; voffB[i] = (unsigned)(Rb * K + C) * 2u; }
    const size_t kstep = (size_t)(BK * 2);
    const size_t hstep = (size_t)HALF * K * 2;
    const size_t tstep = 2 * hstep;
    const unsigned ldsw = (unsigned)wid * 1024u;
    const int aoff = lds_byte(wr * 64 + fr, fq * 8), boff = lds_byte(wc * 32 + fr, fq * 8);
#define PG8_SA(b, h) (((b) * 2 + (h)) * HTB)
#define PG8_SB(b, h) ((4 + (b) * 2 + (h)) * HTB)
#define PG8_STAGE(bufoff, gbase, voff) do { _Pragma("unroll") for (int _i = 0; _i < 2; ++_i) \
        __builtin_amdgcn_global_load_lds((const unsigned*)((const char*)(gbase) + (voff)[_i]), (PG8_LAS unsigned*)(lds + (bufoff) + ldsw + _i * 8192), 16, 0, 0); } while (0)
#define PG8_LDA(dst, b, h) do { _Pragma("unroll") for (int m = 0; m < 4; ++m) _Pragma("unroll") for (int k = 0; k < 2; ++k) dst[m][k] = *(const PG8_LAS bf16x8*)(lds + PG8_SA(b, h) + aoff + m * 2048 + k * 1024); } while (0)
#define PG8_LDB(dst, b, h) do { _Pragma("unroll") for (int n = 0; n < 2; ++n) _Pragma("unroll") for (int k = 0; k < 2; ++k) dst[n][k] = *(const PG8_LAS bf16x8*)(lds + PG8_SB(b, h) + boff + n * 2048 + k * 1024); } while (0)
#define PG8_MMA(ai, bj, At, Bt) do { __builtin_amdgcn_s_setprio(1); _Pragma("unroll") for (int m = 0; m < 4; ++m) _Pragma("unroll") for (int n = 0; n < 2; ++n) _Pragma("unroll") for (int k = 0; k < 2; ++k) \
        acc[ai][bj][m][n] = __builtin_amdgcn_mfma_f32_16x16x32_bf16(Bt[n][k], At[m][k], acc[ai][bj][m][n], 0, 0, 0); __builtin_amdgcn_s_setprio(0); } while (0)
#define PG8_WAIT_V(n) asm volatile("s_waitcnt vmcnt(" #n ")" ::: "memory")
#define PG8_WAIT_L(n) asm volatile("s_waitcnt lgkmcnt(" #n ")" ::: "memory")
#define PG8_BAR __builtin_amdgcn_s_barrier()
#define PG8_SCHED __builtin_amdgcn_sched_barrier(0)
    Unit cur, nxt; int ui = 0;
    if (!S.next(0, cur)) return;
    f32x4 acc[2][2][4][2];
#pragma unroll
    for (int a = 0; a < 2; ++a)
#pragma unroll
        for (int b = 0; b < 2; ++b)
#pragma unroll
            for (int m = 0; m < 4; ++m)
#pragma unroll
                for (int n = 0; n < 2; ++n) acc[a][b][m][n] = (f32x4){0.f, 0.f, 0.f, 0.f};
    bf16x8 At[4][2], B0[2][2], B1[2][2];
    const char* cA = (const char*)g.A + (size_t)cur.pm * tstep; const char* cB = (const char*)g.Bt + (size_t)cur.pn * tstep;
    S.a_ready(cur);
    if constexpr (SP2) {
        PG8_STAGE(PG8_SB(0, 0), cB, voffB); PG8_STAGE(PG8_SB(0, 1), cB + hstep, voffB); PG8_STAGE(PG8_SA(0, 0), cA, voffA); PG8_STAGE(PG8_SA(0, 1), cA + hstep, voffA);
        if (wr == 1) PG8_BAR;
        PG8_WAIT_V(2); PG8_BAR;
        PG8_STAGE(PG8_SB(1, 0), cB + kstep, voffB); PG8_STAGE(PG8_SA(1, 0), cA + kstep, voffA); PG8_STAGE(PG8_SB(1, 1), cB + hstep + kstep, voffB);
        PG8_WAIT_V(6); PG8_BAR;
    } else {
        PG8_STAGE(PG8_SB(0, 0), cB, voffB); PG8_STAGE(PG8_SA(0, 0), cA, voffA); PG8_STAGE(PG8_SB(0, 1), cB + hstep, voffB); PG8_STAGE(PG8_SA(0, 1), cA + hstep, voffA);
        if (wr == 1) PG8_BAR;
        PG8_WAIT_V(4); PG8_BAR;
        PG8_STAGE(PG8_SB(1, 0), cB + kstep, voffB); PG8_STAGE(PG8_SA(1, 0), cA + kstep, voffA); PG8_STAGE(PG8_SB(1, 1), cB + hstep + kstep, voffB);
        PG8_WAIT_V(6); PG8_BAR;
    }
    for (;;) {
        const bool has_next = S.next(ui + 1, nxt);
        const char* nA = has_next ? (const char*)g.A + (size_t)nxt.pm * tstep : cA; const char* nB = has_next ? (const char*)g.Bt + (size_t)nxt.pn * tstep : cB;
        for (int t = 0; t < nt; t += 2) {
            const bool last = (t == nt - 2);
            const char* a1 = cA + (size_t)(t + 1) * kstep;
            const char* a2 = last ? nA : cA + (size_t)(t + 2) * kstep; const char* b2 = last ? nB : cB + (size_t)(t + 2) * kstep;
            const char* a3 = a2 + kstep; const char* b3 = b2 + kstep;
            if (last && has_next) S.a_ready(nxt);
            if constexpr (SP2) {
            PG8_LDB(B0, 0, 0); PG8_LDB(B1, 0, 1); PG8_SCHED; PG8_LDA(At, 0, 0); PG8_STAGE(PG8_SA(1, 1), a1 + hstep, voffA);
            PG8_WAIT_V(8); PG8_WAIT_L(0); PG8_BAR; PG8_MMA(0, 0, At, B0); PG8_MMA(0, 1, At, B1); PG8_BAR; PG8_SCHED;
            PG8_LDA(At, 0, 1); PG8_STAGE(PG8_SB(0, 0), b2, voffB); PG8_STAGE(PG8_SB(0, 1), b2 + hstep, voffB); PG8_STAGE(PG8_SA(0, 0), a2, voffA);
            PG8_WAIT_V(8); PG8_WAIT_L(0); PG8_BAR; PG8_MMA(1, 0, At, B0); PG8_MMA(1, 1, At, B1); PG8_BAR; PG8_SCHED;
            PG8_LDB(B0, 1, 0); PG8_LDB(B1, 1, 1); PG8_SCHED; PG8_LDA(At, 1, 0); PG8_STAGE(PG8_SA(0, 1), a2 + hstep, voffA);
            PG8_WAIT_V(8); PG8_WAIT_L(0); PG8_BAR; PG8_MMA(0, 0, At, B0); PG8_MMA(0, 1, At, B1); PG8_BAR; PG8_SCHED;
            PG8_LDA(At, 1, 1); PG8_STAGE(PG8_SB(1, 0), b3, voffB); PG8_STAGE(PG8_SB(1, 1), b3 + hstep, voffB); PG8_STAGE(PG8_SA(1, 0), a3, voffA);
            PG8_WAIT_V(8); PG8_WAIT_L(0); PG8_BAR; PG8_MMA(1, 0, At, B0); PG8_MMA(1, 1, At, B1); PG8_BAR; PG8_SCHED;
            } else {
            PG8_LDB(B0, 0, 0); PG8_SCHED; PG8_LDA(At, 0, 0); PG8_STAGE(PG8_SA(1, 1), a1 + hstep, voffA);
            PG8_WAIT_L(8); PG8_BAR; PG8_WAIT_L(0); PG8_MMA(0, 0, At, B0); PG8_BAR; PG8_SCHED;
            PG8_LDB(B1, 0, 1); PG8_STAGE(PG8_SB(0, 0), b2, voffB);
            PG8_BAR; PG8_WAIT_L(0); PG8_MMA(0, 1, At, B1); PG8_BAR;
            PG8_LDA(At, 0, 1); PG8_STAGE(PG8_SA(0, 0), a2, voffA);
            PG8_BAR; PG8_WAIT_L(0); PG8_MMA(1, 0, At, B0); PG8_BAR; PG8_SCHED;
            PG8_STAGE(PG8_SB(0, 1), b2 + hstep, voffB);
            PG8_WAIT_V(6); PG8_BAR; PG8_MMA(1, 1, At, B1); PG8_BAR;
            PG8_LDB(B0, 1, 0); PG8_SCHED; PG8_LDA(At, 1, 0); PG8_STAGE(PG8_SA(0, 1), a2 + hstep, voffA);
            PG8_WAIT_L(8); PG8_BAR; PG8_WAIT_L(0); PG8_MMA(0, 0, At, B0); PG8_BAR; PG8_SCHED;
            PG8_LDB(B1, 1, 1); PG8_STAGE(PG8_SB(1, 0), b3, voffB);
            PG8_BAR; PG8_WAIT_L(0); PG8_MMA(0, 1, At, B1); PG8_BAR;
            PG8_LDA(At, 1, 1); PG8_STAGE(PG8_SA(1, 0), a3, voffA);
            PG8_BAR; PG8_WAIT_L(0); PG8_MMA(1, 0, At, B0); PG8_BAR; PG8_SCHED;
            PG8_STAGE(PG8_SB(1, 1), b3 + hstep, voffB);
            PG8_WAIT_V(6); PG8_BAR; PG8_MMA(1, 1, At, B1); PG8_BAR;
            }
        }
        if constexpr (ALIGN_EPI) { if (wr == 0) PG8_BAR; }
        if constexpr (!Epi::AFTER_DRAIN) { E(acc, cur, wr, wc, fr, fq); S.done(cur); }
        if (!has_next) break;
#pragma unroll
        for (int a = 0; a < 2; ++a)
#pragma unroll
            for (int b = 0; b < 2; ++b)
#pragma unroll
                for (int m = 0; m < 4; ++m)
#pragma unroll
                    for (int n = 0; n < 2; ++n) acc[a][b][m][n] = (f32x4){0.f, 0.f, 0.f, 0.f};
        cur = nxt; cA = nA; cB = nB; ++ui;
        if constexpr (ALIGN_EPI) { if (wr == 1) PG8_BAR; }
    }
    PG8_WAIT_V(0);
    if constexpr (!ALIGN_EPI) { if (wr == 0) PG8_BAR; }
    PG8_BAR;
    if constexpr (Epi::AFTER_DRAIN) { E.fused(acc, cur, wr, wc, fr, fq, lds, wid, lane); S.done(cur); }
#undef PG8_SA
#undef PG8_SB
#undef PG8_STAGE
#undef PG8_LDA
#undef PG8_LDB
#undef PG8_MMA
#undef PG8_WAIT_V
#undef PG8_WAIT_L
#undef PG8_BAR
#undef PG8_SCHED
}
}

namespace cg = cooperative_groups;
using pg8::bf16_t; using pg8::bf16x8; using pg8::f32x4; using pg8::u32x4;
#define LAS __attribute__((address_space(3)))
typedef unsigned u32x2 __attribute__((ext_vector_type(2)));
constexpr int D = 1024, MX = 32768, MALL = 33280, DFF = 2816, INC = 4608;
constexpr int NWAVES = 8, NTHREADS = 512, LDS_BYTES = 163840;
constexpr float EPS = 1e-6f, LOG2E = 1.4426950408889634f, QSCALE = 0.125f * 1.4426950408889634f;

constexpr size_t MiB = 1u << 20;
constexpr size_t CTL_MOD = 0;
constexpr size_t CTL_STATS = 221184;
constexpr size_t CTL_ROPE = 753664;
constexpr size_t CTL_CNT = 794624;
constexpr size_t CTL_BAR = 802816;
constexpr size_t CTL_XBAR = 819200;
constexpr size_t CTL_BYTES = 1 * MiB;
constexpr int LDS_BARST = 163840 - 64;
constexpr int LDS_CK = 0, LDS_CV = 65536, LDS_RPB = 131072, LDS_OT = 145952;
static_assert(LDS_OT + 16384 <= LDS_BARST && LDS_RPB + 8 * 465 * 4 <= LDS_OT, "attention LDS map");
static_assert(CTL_STATS == 2 * 3 * 9216 * 4 && CTL_ROPE == CTL_STATS + 2 * 33280 * 2 * 4 && CTL_CNT == CTL_ROPE + 320 * 128 && CTL_CNT + 8 * 256 <= CTL_BYTES, "ctl map");
constexpr size_t WS_W = 1 * MiB, W_LAYER = 49 * MiB;
constexpr size_t W_UP1 = 0, W_DN1 = 11 * MiB, W_IN = W_DN1 + 5 * MiB + MiB / 2, W_PAB = W_IN + 9 * MiB, W_O = W_PAB + 4 * MiB, W_UP2 = W_O + 2 * MiB, W_DN2 = W_UP2 + 11 * MiB, W_S = W_DN2 + 5 * MiB + MiB / 2;
static_assert(W_S + 131072 <= W_LAYER, "weights map");
constexpr size_t WS_XC = WS_W + 2 * W_LAYER;
constexpr size_t WS_H = WS_XC + 2 * MiB;
constexpr size_t WS_MIX = WS_H + 65 * MiB;
constexpr size_t WS_QU = WS_MIX;
constexpr size_t WS_KB = WS_QU + 65 * MiB;
constexpr size_t WS_VT = WS_KB + 32 * MiB + MiB / 2;
constexpr size_t WS_VST = WS_VT + 32 * MiB + MiB / 2;
constexpr size_t WS_GT = WS_VST + 32 * MiB + MiB / 2;
constexpr size_t WS_END = WS_GT + 130 * MiB;
constexpr size_t WS_MRG = WS_KB;
constexpr size_t WS_G = WS_MIX;
static_assert((size_t)MALL * DFF * 2 <= WS_END - WS_MIX && WS_END <= 512 * MiB, "ws map");

struct Args { const float* in[22]; float* out; unsigned char* ws; };
typedef const __attribute__((address_space(4))) unsigned long long* kptr_t;
#define GAS __attribute__((address_space(1)))
#define KPTR(T, i) ((T*)(GAS T*)kp[(i)])

__device__ __forceinline__ float wave_sum(float v) {
#pragma unroll
    for (int o = 1; o < 64; o <<= 1) v += __shfl_xor(v, o);
    return v;
}
typedef float f32x2_t __attribute__((ext_vector_type(2))); typedef __bf16 bf16x2_t __attribute__((ext_vector_type(2)));
__device__ __forceinline__ unsigned cvtpk_s(float lo, float hi) { f32x2_t v = {lo, hi}; bf16x2_t b = __builtin_convertvector(v, bf16x2_t); return __builtin_bit_cast(unsigned, b); }
#define LDS_WAIT() asm volatile("s_waitcnt lgkmcnt(0)" ::: "memory")

__device__ __forceinline__ void transpose_item(const float* W, int N, bf16_t* WT, int ldw, int drow0, int dk0, LAS float* scr, int k0, int n0, int lane) {
#pragma unroll 8
    for (int i = 0; i < 32; ++i) { const int kk = 2 * i + (lane >> 5); scr[kk * 33 + (lane & 31)] = W[(size_t)(k0 + kk) * N + n0 + (lane & 31)]; }
    LDS_WAIT(); asm volatile("" ::: "memory");
    const int c = lane & 7;
#pragma unroll
    for (int j = 0; j < 4; ++j) { const int n = (lane >> 3) + 8 * j; const LAS float* s = scr + (8 * c) * 33 + n;
        u32x4 o; o.x = cvtpk_s(s[0 * 33], s[1 * 33]); o.y = cvtpk_s(s[2 * 33], s[3 * 33]); o.z = cvtpk_s(s[4 * 33], s[5 * 33]); o.w = cvtpk_s(s[6 * 33], s[7 * 33]);
        *(u32x4*)(WT + (size_t)(drow0 + n) * ldw + dk0 + k0 + 8 * c) = o; }
    LDS_WAIT(); asm volatile("" ::: "memory");
}
__device__ __forceinline__ int up_row(int n0) { return n0 < DFF ? 256 * (n0 / 128) + (n0 % 128) : 256 * ((n0 - DFF) / 128) + 128 + ((n0 - DFF) % 128); }

constexpr int IT_UP = 16 * 176, IT_DN = 44 * 32, IT_IN = 16 * 144, IT_P = 8 * 32, IT_O = 16 * 32, IT_Z = 2048, IT_S = 128;
constexpr int IT_LAYER = 2 * IT_UP + 2 * IT_DN + IT_IN + 2 * IT_P + IT_O + IT_Z + IT_S;
constexpr int IT_ADA = 2 * 36 * 16, IT_XC = 2048, IT_ROPE = 80;
constexpr int IT_TOTAL = IT_ADA + 2 * IT_LAYER + IT_XC + IT_ROPE;

__device__ __forceinline__ void prologue(const kptr_t kp, LAS float* scr, int gw, int NGW, int lane) {
    unsigned char* ws = KPTR(unsigned char, 23);
    for (int it = gw; it < IT_TOTAL; it += NGW) {
        int r = it;
        if (r < IT_ADA) {
            const int l = r / 576, rem = r % 576, cgp = rem / 16, ks = rem % 16, j0 = cgp * 256 + 4 * lane;
            const float* c = KPTR(const float, 1); const float* cc = KPTR(const float, 3);
            const float* wp = KPTR(const float, 4) + ((size_t)l * 1024 + ks * 64) * 9216 + j0;
            f32x4 a0 = {0.f, 0.f, 0.f, 0.f}, a1 = a0, a2 = a0;
#pragma unroll 4
            for (int kk = 0; kk < 64; ++kk) {
                const int k = ks * 64 + kk; const float x0 = c[k], x1 = c[1024 + k], x2 = cc[k];
                const float s0 = x0 / (1.0f + expf(-x0)), s1 = x1 / (1.0f + expf(-x1)), s2 = x2 / (1.0f + expf(-x2));
                const f32x4 w = *(const f32x4*)(wp + (size_t)kk * 9216);
                a0 += w * s0; a1 += w * s1; a2 += w * s2;
            }
            if (ks == 0) { const f32x4 b = *(const f32x4*)(KPTR(const float, 5) + l * 9216 + j0); a0 += b; a1 += b; a2 += b; }
            float* m = (float*)(ws + CTL_MOD) + (size_t)l * 3 * 9216 + j0;
#pragma unroll
            for (int e = 0; e < 4; ++e) { unsafeAtomicAdd(m + e, a0[e]); unsafeAtomicAdd(m + 9216 + e, a1[e]); unsafeAtomicAdd(m + 18432 + e, a2[e]); }
            continue;
        }
        r -= IT_ADA;
        if (r < 2 * IT_LAYER) {
            const int l = r / IT_LAYER; r -= l * IT_LAYER;
            unsigned char* wl = ws + WS_W + (size_t)l * W_LAYER;
            if (r < IT_UP) { const int kb = r / 176, nb = r % 176; transpose_item(KPTR(const float, 7) + (size_t)l * D * 2 * DFF, 2 * DFF, (bf16_t*)(wl + W_UP1), D, up_row(32 * nb), 0, scr, 64 * kb, 32 * nb, lane); continue; } r -= IT_UP;
            if (r < IT_DN) { const int kb = r / 32, nb = r % 32; transpose_item(KPTR(const float, 8) + (size_t)l * DFF * D, D, (bf16_t*)(wl + W_DN1), DFF, 32 * nb, 0, scr, 64 * kb, 32 * nb, lane); continue; } r -= IT_DN;
            if (r < IT_IN) { const int kb = r / 144, nb = r % 144; transpose_item(KPTR(const float, 9) + (size_t)l * D * INC, INC, (bf16_t*)(wl + W_IN), D, 32 * nb, 0, scr, 64 * kb, 32 * nb, lane); continue; } r -= IT_IN;
            if (r < IT_P) { const int kb = r / 32, nb = r % 32, n0 = 32 * nb; transpose_item(KPTR(const float, 16) + (size_t)l * 512 * D, D, (bf16_t*)(wl + W_PAB), D, 256 * (n0 / 128) + (n0 % 128), 0, scr, 64 * kb, n0, lane); continue; } r -= IT_P;
            if (r < IT_P) { const int kb = r / 32, nb = r % 32, n0 = 32 * nb; transpose_item(KPTR(const float, 17) + (size_t)l * 512 * D, D, (bf16_t*)(wl + W_PAB), D, 256 * (n0 / 128) + 128 + (n0 % 128), 512, scr, 64 * kb, n0, lane); continue; } r -= IT_P;
            if (r < IT_O) { const int kb = r / 32, nb = r % 32; transpose_item(KPTR(const float, 18) + (size_t)l * D * D, D, (bf16_t*)(wl + W_O), D, 32 * nb, 0, scr, 64 * kb, 32 * nb, lane); continue; } r -= IT_O;
            if (r < IT_UP) { const int kb = r / 176, nb = r % 176; transpose_item(KPTR(const float, 19) + (size_t)l * D * 2 * DFF, 2 * DFF, (bf16_t*)(wl + W_UP2), D, up_row(32 * nb), 0, scr, 64 * kb, 32 * nb, lane); continue; } r -= IT_UP;
            if (r < IT_DN) { const int kb = r / 32, nb = r % 32; transpose_item(KPTR(const float, 20) + (size_t)l * DFF * D, D, (bf16_t*)(wl + W_DN2), DFF, 32 * nb, 0, scr, 64 * kb, 32 * nb, lane); continue; } r -= IT_DN;
            if (r < IT_Z) {
                const int zk0 = ((r & 255) < 128) ? 512 : 0;
                *(u32x4*)((bf16_t*)(wl + W_PAB) + (size_t)r * D + zk0 + 8 * lane) = (u32x4){0u, 0u, 0u, 0u}; continue; } r -= IT_Z;
            {
                const float* s = KPTR(const float, 14) + (size_t)l * 65536 + (size_t)(r * 64 + lane) * 8; const f32x4 v0 = *(const f32x4*)s, v1 = *(const f32x4*)(s + 4);
                u32x4 o; o.x = cvtpk_s(v0[0], v0[1]); o.y = cvtpk_s(v0[2], v0[3]); o.z = cvtpk_s(v1[0], v1[1]); o.w = cvtpk_s(v1[2], v1[3]);
                *(u32x4*)((bf16_t*)(wl + W_S) + (size_t)(r * 64 + lane) * 8) = o; continue; }
        }
        r -= 2 * IT_LAYER;
        if (r < IT_XC) { const size_t idx = (size_t)(r * 64 + lane) * 4; *(f32x4*)((float*)(ws + WS_XC) + idx) = *(const f32x4*)(KPTR(const float, 2) + idx); continue; }
        r -= IT_XC;
        {
            const int id = r * 64 + lane, pos = id >> 4, j = id & 15; const int p = pos < 256 ? pos : pos - 256;
            const float freq = powf(10000.0f, -(float)j / 16.0f); const float ang = (float)p * freq;
            float* t = (float*)(ws + CTL_ROPE) + (size_t)id * 2; t[0] = cosf(ang); t[1] = sinf(ang);
        }
    }
}

__device__ __forceinline__ void modpass(const float* xs_main, const float* xs_ctx, const float* mod_l, const float* g, int i, bf16_t* H, int nrows, int gw, int NGW, int lane) {
    f32x4 gm[2][2], sh[2][2], v[2][2], vn[2][2]; int cur = -1;
    int row = gw;
    if (row < nrows) { const float* xr = row < MX ? xs_main + (size_t)row * D : xs_ctx + (size_t)(row - MX) * D;
#pragma unroll
        for (int j = 0; j < 2; ++j) { v[j][0] = *(const f32x4*)(xr + 8 * lane + 512 * j); v[j][1] = *(const f32x4*)(xr + 8 * lane + 512 * j + 4); } }
    for (; row < nrows; row += NGW) {
        const int nrow = row + NGW;
        if (nrow < nrows) { const float* xr = nrow < MX ? xs_main + (size_t)nrow * D : xs_ctx + (size_t)(nrow - MX) * D;
#pragma unroll
            for (int j = 0; j < 2; ++j) { vn[j][0] = *(const f32x4*)(xr + 8 * lane + 512 * j); vn[j][1] = *(const f32x4*)(xr + 8 * lane + 512 * j + 4); } }
        const int cond = row < 16384 ? 0 : (row < MX ? 1 : 2);
        if (cond != cur) { cur = cond; const float* shift = mod_l + cond * 9216 + 3 * i * 1024; const float* scale = shift + 1024;
#pragma unroll
            for (int j = 0; j < 2; ++j)
#pragma unroll
                for (int q = 0; q < 2; ++q) { const int c = 8 * lane + 512 * j + 4 * q; gm[j][q] = *(const f32x4*)(g + c) * (*(const f32x4*)(scale + c) + 1.0f); sh[j][q] = *(const f32x4*)(shift + c); } }
        float ss = 0.f;
#pragma unroll
        for (int j = 0; j < 2; ++j)
#pragma unroll
            for (int q = 0; q < 2; ++q) ss += (v[j][q][0] * v[j][q][0] + v[j][q][1] * v[j][q][1]) + (v[j][q][2] * v[j][q][2] + v[j][q][3] * v[j][q][3]);
        const float rstd = 1.0f / sqrtf(wave_sum(ss) * (1.0f / D) + EPS);
#pragma unroll
        for (int j = 0; j < 2; ++j) {
            const f32x4 o0 = v[j][0] * rstd * gm[j][0] + sh[j][0], o1 = v[j][1] * rstd * gm[j][1] + sh[j][1];
            u32x4 w; w.x = cvtpk_s(o0[0], o0[1]); w.y = cvtpk_s(o0[2], o0[3]); w.z = cvtpk_s(o1[0], o1[1]); w.w = cvtpk_s(o1[2], o1[3]);
            *(u32x4*)(H + (size_t)row * D + 8 * lane + 512 * j) = w;
        }
#pragma unroll
        for (int j = 0; j < 2; ++j) { v[j][0] = vn[j][0]; v[j][1] = vn[j][1]; }
    }
}
__device__ __forceinline__ void final_norm(float* out, const float* g, int gw, int NGW, int lane) {
    f32x4 gg[4];
#pragma unroll
    for (int j = 0; j < 4; ++j) gg[j] = *(const f32x4*)(g + 4 * lane + 256 * j);
    f32x4 v[4], vn[4]; int row = gw;
    if (row < MX) {
#pragma unroll
        for (int j = 0; j < 4; ++j) v[j] = *(const f32x4*)(out + (size_t)row * D + 4 * lane + 256 * j); }
    for (; row < MX; row += NGW) {
        const int nrow = row + NGW;
        if (nrow < MX) {
#pragma unroll
            for (int j = 0; j < 4; ++j) vn[j] = *(const f32x4*)(out + (size_t)nrow * D + 4 * lane + 256 * j); }
        float ss = 0.f;
#pragma unroll
        for (int j = 0; j < 4; ++j) ss += (v[j][0] * v[j][0] + v[j][1] * v[j][1]) + (v[j][2] * v[j][2] + v[j][3] * v[j][3]);
        const float rstd = 1.0f / sqrtf(wave_sum(ss) * (1.0f / D) + EPS);
#pragma unroll
        for (int j = 0; j < 4; ++j) *(f32x4*)(out + (size_t)row * D + 4 * lane + 256 * j) = v[j] * rstd * gg[j];
#pragma unroll
        for (int j = 0; j < 4; ++j) v[j] = vn[j];
    }
}

#define MFMA16(a, b, c) __builtin_amdgcn_mfma_f32_16x16x32_bf16((a), (b), (c), 0, 0, 0)
__device__ __forceinline__ int wq_next(unsigned* cnt, int lane) { unsigned v = 0u; if (lane == 0) v = atomicAdd(cnt, 1u); return (int)__builtin_amdgcn_readfirstlane(v); }

__device__ __forceinline__ void attn_unit(int u, const bf16_t* KB, const bf16_t* VT, const bf16_t* QU, bf16_t* OB, const LAS float* rpb_l, LAS unsigned char* ot, const LAS unsigned char* ckl, const LAS unsigned char* cvl, int lane_) {
    int lane = lane_; asm volatile("" : "+v"(lane));
    const int fr = lane & 15, fq = lane >> 4;
    const bool isx = u < 16384;
    int b, h, cb, r = 0, qrow0, rs = 0, c0 = 0;
    if (isx) { cb = u & 3; h = (u >> 2) & 7; r = (u >> 5) & 255; b = u >> 13; qrow0 = b * 16384 + r * 64 + 16 * cb; rs = min(max(r - 4, 0), 248); c0 = (cb == 0) ? 0 : (cb == 1 ? 8 : (cb == 2 ? 24 : 32)); }
    else { const int uu = u - 16384; cb = uu & 3; h = (uu >> 2) & 7; const int rg = (uu >> 5) & 3; b = uu >> 7; qrow0 = MX + b * 256 + rg * 64 + 16 * cb; }
    bf16x8 bq0, bq1; { const bf16_t* qp = QU + (size_t)(qrow0 + fr) * 1024 + h * 64 + 8 * fq; bq0 = *(const bf16x8*)qp; bq1 = *(const bf16x8*)(qp + 32); }
    const int kk0 = 8 * (fr >> 2) + (fr & 3);
    const f32x4 z4 = {0.f, 0.f, 0.f, 0.f};
    const float NEG = -INFINITY;
    f32x4 st[8][2];
    f32x4 o[4] = {z4, z4, z4, z4};
    float m = NEG, l = 0.f;
    bf16x8 fb[32];
#define ATTN_SB() __builtin_amdgcn_sched_barrier(0)
    if (isx) {
        const bf16_t* kp0 = KB + ((size_t)h * MALL + (b * 16384 + rs * 64 + c0 + kk0)) * 64 + 8 * fq;
#pragma unroll
        for (int i = 0; i < 8; ++i)
#pragma unroll
            for (int t = 0; t < 2; ++t) { const bf16_t* kp = kp0 + (size_t)(i * 64 + 4 * t) * 64; fb[i * 4 + t * 2] = *(const bf16x8*)kp; fb[i * 4 + t * 2 + 1] = *(const bf16x8*)(kp + 32); }
        ATTN_SB();
#pragma unroll
        for (int i = 0; i < 8; ++i)
#pragma unroll
            for (int t = 0; t < 2; ++t) { f32x4 s = MFMA16(fb[i * 4 + t * 2], bq0, z4); s = MFMA16(fb[i * 4 + t * 2 + 1], bq1, s); st[i][t] = s; }
        ATTN_SB();
        const bf16_t* vp0 = VT + ((size_t)(((b * 16384 + rs * 64 + c0) >> 3) + fq) * 512 + h * 64 + fr) * 8;
#pragma unroll
        for (int i = 0; i < 8; ++i)
#pragma unroll
            for (int dt = 0; dt < 4; ++dt) fb[i * 4 + dt] = *(const bf16x8*)(vp0 + (size_t)(i * 8 * 512 + dt * 16) * 8);
        ATTN_SB();
        const int c = 16 * cb + fr, cs = min(max(c - 8, 0), 48); const LAS float* rp = rpb_l + h * 465 + (rs - r + 7) * 31;
#pragma unroll
        for (int t = 0; t < 2; ++t)
#pragma unroll
            for (int e = 0; e < 4; ++e) { const int kc = c0 + 8 * fq + 4 * t + e; const bool valid = (kc >= cs) && (kc < cs + 16); const int dc = min(max(kc - c + 15, 0), 30);
                float bz[8];
#pragma unroll
                for (int i = 0; i < 8; ++i) bz[i] = rp[i * 31 + dc];
                asm volatile("" : "+v"(bz[0]), "+v"(bz[1]), "+v"(bz[2]), "+v"(bz[3]), "+v"(bz[4]), "+v"(bz[5]), "+v"(bz[6]), "+v"(bz[7]));
#pragma unroll
                for (int i = 0; i < 8; ++i) st[i][t][e] = valid ? st[i][t][e] + bz[i] : NEG; }
#pragma unroll
        for (int g = 0; g < 8; ++g)
#pragma unroll
            for (int t = 0; t < 2; ++t) m = fmaxf(m, fmaxf(fmaxf(st[g][t][0], st[g][t][1]), fmaxf(st[g][t][2], st[g][t][3])));
        m = fmaxf(m, __shfl_xor(m, 16)); m = fmaxf(m, __shfl_xor(m, 32));
#pragma unroll
        for (int g = 0; g < 8; ++g)
#pragma unroll
            for (int t = 0; t < 2; ++t)
#pragma unroll
                for (int e = 0; e < 4; ++e) { const float p = __builtin_amdgcn_exp2f(st[g][t][e] - m); st[g][t][e] = p; l += p; }
        ATTN_SB();
#pragma unroll
        for (int i = 0; i < 8; ++i) {
            u32x4 pw; pw.x = cvtpk_s(st[i][0][0], st[i][0][1]); pw.y = cvtpk_s(st[i][0][2], st[i][0][3]); pw.z = cvtpk_s(st[i][1][0], st[i][1][1]); pw.w = cvtpk_s(st[i][1][2], st[i][1][3]);
            const bf16x8 pa = __builtin_bit_cast(bf16x8, pw);
#pragma unroll
            for (int dt = 0; dt < 4; ++dt) o[dt] = MFMA16(pa, fb[i * 4 + dt], o[dt]);
        }
        ATTN_SB();
    }
    {
        {
            const int sw = (fr >> 2) * 2 + ((fr >> 1) & 1);
            const LAS unsigned char* k0 = ckl + kk0 * 128 + ((fq ^ sw) << 4); const LAS unsigned char* k1 = ckl + kk0 * 128 + (((fq + 4) ^ sw) << 4);
#pragma unroll
            for (int j = 0; j < 8; ++j)
#pragma unroll
                for (int t = 0; t < 2; ++t) { fb[j * 4 + t * 2] = *(const LAS bf16x8*)(k0 + j * 4096 + t * 512); fb[j * 4 + t * 2 + 1] = *(const LAS bf16x8*)(k1 + j * 4096 + t * 512); }
        }
        ATTN_SB();
#pragma unroll
        for (int j = 0; j < 8; ++j)
#pragma unroll
            for (int t = 0; t < 2; ++t) { f32x4 s = MFMA16(fb[j * 4 + t * 2], bq0, z4); s = MFMA16(fb[j * 4 + t * 2 + 1], bq1, s); st[j][t] = s; }
        ATTN_SB();
        {
            const LAS unsigned char* v0 = cvl + fr * 512;
#pragma unroll
            for (int j = 0; j < 8; ++j) { const int xo = ((4 * j + fq) ^ fr) << 4;
#pragma unroll
                for (int dt = 0; dt < 4; ++dt) fb[j * 4 + dt] = *(const LAS bf16x8*)(v0 + dt * 8192 + xo); }
        }
        ATTN_SB();
        float m2 = NEG;
#pragma unroll
        for (int g = 0; g < 8; ++g)
#pragma unroll
            for (int t = 0; t < 2; ++t) m2 = fmaxf(m2, fmaxf(fmaxf(st[g][t][0], st[g][t][1]), fmaxf(st[g][t][2], st[g][t][3])));
        m2 = fmaxf(m2, __shfl_xor(m2, 16)); m2 = fmaxf(m2, __shfl_xor(m2, 32));
        const float mn = fmaxf(m, m2);
        const float alpha = __builtin_amdgcn_exp2f(m - mn);
        l *= alpha;
#pragma unroll
        for (int e = 0; e < 4; ++e) { const float aq = __shfl(alpha, 4 * fq + e);
#pragma unroll
            for (int dt = 0; dt < 4; ++dt) o[dt][e] *= aq; }
#pragma unroll
        for (int g = 0; g < 8; ++g)
#pragma unroll
            for (int t = 0; t < 2; ++t)
#pragma unroll
                for (int e = 0; e < 4; ++e) { const float p = __builtin_amdgcn_exp2f(st[g][t][e] - mn); st[g][t][e] = p; l += p; }
        ATTN_SB();
#pragma unroll
        for (int j = 0; j < 8; ++j) {
            u32x4 pw; pw.x = cvtpk_s(st[j][0][0], st[j][0][1]); pw.y = cvtpk_s(st[j][0][2], st[j][0][3]); pw.z = cvtpk_s(st[j][1][0], st[j][1][1]); pw.w = cvtpk_s(st[j][1][2], st[j][1][3]);
            const bf16x8 pa = __builtin_bit_cast(bf16x8, pw);
#pragma unroll
            for (int dt = 0; dt < 4; ++dt) o[dt] = MFMA16(pa, fb[j * 4 + dt], o[dt]);
        }
    }
    __builtin_amdgcn_sched_barrier(0);
    l += __shfl_xor(l, 16); l += __shfl_xor(l, 32);
    const float inv = 1.0f / l;
    asm volatile("" ::: "memory");
#pragma unroll
    for (int e = 0; e < 4; ++e) { const float il = __shfl(inv, 4 * fq + e);
#pragma unroll
        for (int dt = 0; dt < 4; ++dt) *(LAS unsigned short*)(ot + (4 * fq + e) * 128 + (dt * 16 + fr) * 2) = pg8::f2bf_rne(o[dt][e] * il); }
    asm volatile("" ::: "memory");
#pragma unroll
    for (int k = 0; k < 2; ++k) { const int p = lane + 64 * k, q = p >> 3, dc = p & 7;
        const u32x4 w = *(const LAS u32x4*)(ot + q * 128 + dc * 16);
        *(u32x4*)(OB + (size_t)(qrow0 + q) * 1024 + h * 64 + dc * 8) = w; }
    asm volatile("" ::: "memory");
}

template <int NMT> __device__ __forceinline__ void sg_unit(int chunk, int g, int cofs, const bf16_t* VST, const bf16_t* QU, bf16_t* OB, const float* stats, const float* lng, const float* lnb, const bf16_t* WSb, const float* bs, int lane_) {
    int lane = lane_; asm volatile("" : "+v"(lane));
    const int fr = lane & 15, fq = lane >> 4;
    const int R0 = chunk < 256 ? chunk * 128 : MX + (chunk - 256) * 128;
    const int ch0 = g * 128 + cofs;
    u32x4 raw[NMT][4]; pg8::f32x2 sv[4][8];
#pragma unroll
    for (int ks = 0; ks < 4; ++ks) {
#pragma unroll
        for (int j = 0; j < 8; ++j) sv[ks][j] = *(const pg8::f32x2*)(stats + 2 * (size_t)(R0 + ks * 32 + 8 * fq + j));
#pragma unroll
        for (int mt = 0; mt < NMT; ++mt) raw[mt][ks] = *(const u32x4*)(VST + ((size_t)((R0 >> 3) + ks * 4 + fq) * 512 + ch0 + mt * 16 + fr) * 8);
    }
    float lg[NMT], lb[NMT];
#pragma unroll
    for (int mt = 0; mt < NMT; ++mt) { lg[mt] = lng[ch0 + mt * 16 + fr]; lb[mt] = lnb[ch0 + mt * 16 + fr]; }
    const bf16_t* wp0 = WSb + (size_t)(g * 128 + fr) * 128 + 8 * fq;
    bf16x8 wf[2][4]; u32x2 uu[2][NMT]; float bsv[2];
#pragma unroll
    for (int ks = 0; ks < 4; ++ks) wf[0][ks] = *(const bf16x8*)(wp0 + ks * 32);
#pragma unroll
    for (int mt = 0; mt < NMT; ++mt) uu[0][mt] = *(const u32x2*)(QU + (size_t)(R0 + fr) * 1024 + 512 + ch0 + mt * 16 + 4 * fq);
    bsv[0] = bs[g * 128 + fr];
    __builtin_amdgcn_sched_barrier(0);
    bf16x8 af[NMT][4];
#pragma unroll
    for (int ks = 0; ks < 4; ++ks) {
        float mu[8], rs[8];
#pragma unroll
        for (int j = 0; j < 8; ++j) { const float mean = sv[ks][j][0] * (1.0f / 512.0f); const float var = fmaxf(sv[ks][j][1] * (1.0f / 512.0f) - mean * mean, 0.f); mu[j] = mean; rs[j] = 1.0f / sqrtf(var + EPS); }
#pragma unroll
        for (int mt = 0; mt < NMT; ++mt) {
            const u32x4 rw = raw[mt][ks];
            float v[8]; v[0] = pg8::bflo(rw.x); v[1] = pg8::bfhi(rw.x); v[2] = pg8::bflo(rw.y); v[3] = pg8::bfhi(rw.y); v[4] = pg8::bflo(rw.z); v[5] = pg8::bfhi(rw.z); v[6] = pg8::bflo(rw.w); v[7] = pg8::bfhi(rw.w);
#pragma unroll
            for (int j = 0; j < 8; ++j) v[j] = (v[j] - mu[j]) * rs[j] * lg[mt] + lb[mt];
            u32x4 pw; pw.x = cvtpk_s(v[0], v[1]); pw.y = cvtpk_s(v[2], v[3]); pw.z = cvtpk_s(v[4], v[5]); pw.w = cvtpk_s(v[6], v[7]);
            af[mt][ks] = __builtin_bit_cast(bf16x8, pw);
        }
    }
    const f32x4 z4 = {0.f, 0.f, 0.f, 0.f};
#pragma unroll
    for (int nt = 0; nt < 8; ++nt) {
        const int cur = nt & 1, nxt = cur ^ 1;
        if (nt < 7) {
#pragma unroll
            for (int ks = 0; ks < 4; ++ks) wf[nxt][ks] = *(const bf16x8*)(wp0 + (size_t)(nt + 1) * 16 * 128 + ks * 32);
#pragma unroll
            for (int mt = 0; mt < NMT; ++mt) uu[nxt][mt] = *(const u32x2*)(QU + (size_t)(R0 + (nt + 1) * 16 + fr) * 1024 + 512 + ch0 + mt * 16 + 4 * fq);
            bsv[nxt] = bs[g * 128 + (nt + 1) * 16 + fr];
        }
        f32x4 a[NMT];
#pragma unroll
        for (int mt = 0; mt < NMT; ++mt) a[mt] = z4;
#pragma unroll
        for (int ks = 0; ks < 4; ++ks)
#pragma unroll
            for (int mt = 0; mt < NMT; ++mt) a[mt] = MFMA16(af[mt][ks], wf[cur][ks], a[mt]);
        const float bv = bsv[cur];
        unsigned q[NMT][2];
#pragma unroll
        for (int mt = 0; mt < NMT; ++mt) { const u32x2 u0 = uu[cur][mt];
            q[mt][0] = cvtpk_s(pg8::bflo(u0.x) * (a[mt][0] + bv), pg8::bfhi(u0.x) * (a[mt][1] + bv)); q[mt][1] = cvtpk_s(pg8::bflo(u0.y) * (a[mt][2] + bv), pg8::bfhi(u0.y) * (a[mt][3] + bv)); }
        const size_t uo = (size_t)(R0 + nt * 16 + fr) * 1024 + 512 + ch0;
#pragma unroll
        for (int mp = 0; mp < NMT / 2; ++mp) { int co; const u32x4 w = pg8::quad_swap(q[2 * mp][0], q[2 * mp][1], q[2 * mp + 1][0], q[2 * mp + 1][1], fq, co); *(u32x4*)(OB + uo + mp * 32 + co) = w; }
    }
}

__device__ __forceinline__ void ctx_resid_gemm(const bf16_t* A  , const bf16_t* Bt  , int K, float* XC, const float* gate  , float coef, int gw, int NGW, int lane) {
    const int fr = lane & 15, fq = lane >> 4;
    for (int tile = gw; tile < 32 * 64; tile += NGW) {
        const int rt = tile >> 6, ct = tile & 63;
        const bf16_t* ap = A + (size_t)(MX + rt * 16 + fr) * K + 8 * fq; const bf16_t* bp = Bt + (size_t)(ct * 16 + fr) * K + 8 * fq;
        f32x4 acc0 = {0.f, 0.f, 0.f, 0.f}, acc1 = acc0;
#pragma unroll 4
        for (int ks = 0; ks < K; ks += 64) {
            acc0 = MFMA16(*(const bf16x8*)(ap + ks), *(const bf16x8*)(bp + ks), acc0);
            acc1 = MFMA16(*(const bf16x8*)(ap + ks + 32), *(const bf16x8*)(bp + ks + 32), acc1);
        }
        const int col = ct * 16 + fr; const float gv = gate[col] * coef;
#pragma unroll
        for (int e = 0; e < 4; ++e) { float* xp = XC + (size_t)(rt * 16 + 4 * fq + e) * D + col; *xp = *xp + gv * (acc0[e] + acc1[e]); }
    }
}

#ifndef MK_SP2
#define MK_SP2 true
#endif
#ifndef MK_ALIGN
#define MK_ALIGN true
#endif
template <class Epi> __device__ __forceinline__ void run_gemm(LAS unsigned char* lds, const bf16_t* A, const bf16_t* Bt, int M, int N, int K, const Epi& E) {
    pg8::Gemm g{A, Bt, M, N, K}; pg8::StaticOrder S; S.init(M, N, (int)gridDim.x, (int)blockIdx.x);
    pg8::gemm_phase<Epi, pg8::StaticOrder, MK_ALIGN, MK_SP2>(lds, g, S, E);
}


__device__ __forceinline__ kptr_t kargs() { kptr_t p = (kptr_t)__builtin_amdgcn_kernarg_segment_ptr(); asm volatile("" : "+s"(p)); return p; }
#define KIN(i) KPTR(const float, i)
#define KOUT() KPTR(float, 22)
#define KWS() KPTR(unsigned char, 23)
#define PH_BEGIN() const kptr_t kp = kargs(); unsigned char* const ws = KWS(); (void)ws; int tid_ = threadIdx.x; asm volatile("" : "+v"(tid_)); const int lane = tid_ & 63, wave = __builtin_amdgcn_readfirstlane(tid_ >> 6); \
    const int gw = blockIdx.x * NWAVES + wave, NGW = gridDim.x * NWAVES; (void)lane; (void)gw; (void)NGW

#define RLX_AGENT __ATOMIC_RELAXED, __HIP_MEMORY_SCOPE_AGENT
#define XB_TMO      128
#define XB_XCNT(j)  (256  + 64 * (j))
#define XB_XSUB(j)  (1280 + 64 * (j))
#define XB_XGEN(j)  (2304 + 64 * (j))
#define XB_TOP      3328
#define XB_TOPGEN   3392
#define XCD_BAR_WORDS 3456
#define XB_SPIN_CAP (1u << 18)

__device__ __forceinline__ unsigned xb_ld(unsigned* p)              { return __hip_atomic_load(p, __ATOMIC_RELAXED, __HIP_MEMORY_SCOPE_AGENT); }
__device__ __forceinline__ unsigned xb_add(unsigned* p, unsigned v) { return __hip_atomic_fetch_add(p, v, __ATOMIC_RELAXED, __HIP_MEMORY_SCOPE_AGENT); }
__device__ __forceinline__ unsigned xb_xcc_id() { return (unsigned)__builtin_amdgcn_s_getreg((3 << 11) | 20) & 0xFu; }
#define XB_SPIN(cond, bar) do { unsigned _sp = 0; while (cond) { __builtin_amdgcn_s_sleep(1); \
    if ((++_sp & 255u) == 0u) { if (xb_ld(&(bar)[XB_TMO])) break; if (_sp > XB_SPIN_CAP) { atomicAdd(&(bar)[XB_TMO], 1u); break; } } } } while (0)

struct XcdBarrier {
    unsigned* bar; unsigned x;
    volatile LAS unsigned* st;
};

__device__ __forceinline__ XcdBarrier xcd_barrier_post(unsigned* bar, volatile LAS unsigned* st) {
    XcdBarrier b; b.bar = bar; b.x = xb_xcc_id(); b.st = st;
    if (threadIdx.x == 0) (void)xb_add(&bar[XB_XCNT(b.x)], 1u);
    return b;
}
__device__ __forceinline__ void xcd_barrier_complete(unsigned* bar, unsigned x, unsigned& nloc, unsigned& nx) {
    const unsigned G = gridDim.x * gridDim.y * gridDim.z;
    unsigned sum, cnt, mine, sp = 0u;
    for (;;) {
        sum = 0u; cnt = 0u; mine = 0u;
#pragma unroll
        for (unsigned j = 0; j < 16; ++j) { const unsigned c = xb_ld(&bar[XB_XCNT(j)]); sum += c; cnt += (c > 0u) ? 1u : 0u; mine = (j == x) ? c : mine; }
        if (sum == G) break;
        __builtin_amdgcn_s_sleep(1);
        if ((++sp & 255u) == 0u) { if (xb_ld(&bar[XB_TMO])) break; if (sp > XB_SPIN_CAP) { atomicAdd(&bar[XB_TMO], 1u); break; } }
    }
    nloc = mine > 0u ? mine : 1u; nx = cnt > 0u ? cnt : 1u;
}

__device__ __forceinline__ void xcd_barrier(const XcdBarrier& b) {
    asm volatile("s_waitcnt vmcnt(0)" ::: "memory");
    __syncthreads();
    if (threadIdx.x == 0) {
        unsigned* bar = b.bar;
        __builtin_amdgcn_s_waitcnt(0);
        unsigned nloc = b.st[0], nx = b.st[1];
        if (nloc == 0u) { xcd_barrier_complete(bar, b.x, nloc, nx); b.st[0] = nloc; b.st[1] = nx; }
        const unsigned old = xb_add(&bar[XB_XSUB(b.x)], 1u);
        const unsigned gen = old / nloc;
        if (old + 1u == (gen + 1u) * nloc) {
            __builtin_amdgcn_fence(__ATOMIC_RELEASE, "agent");
            asm volatile("s_waitcnt vmcnt(0)" ::: "memory");
            const unsigned og = xb_add(&bar[XB_TOP], 1u);
            const unsigned tg = og / nx;
            if (og + 1u == (tg + 1u) * nx) xb_add(&bar[XB_TOPGEN], 1u);
            else XB_SPIN(xb_ld(&bar[XB_TOPGEN]) == tg, bar);
            __builtin_amdgcn_fence(__ATOMIC_ACQUIRE, "agent");
            xb_add(&bar[XB_XGEN(b.x)], 1u);
            asm volatile("s_waitcnt vmcnt(0)" ::: "memory");
        } else {
            XB_SPIN(xb_ld(&bar[XB_XGEN(b.x)]) == gen, bar);
            __builtin_amdgcn_fence(__ATOMIC_ACQUIRE, "agent");
            asm volatile("s_waitcnt vmcnt(0)" ::: "memory");
        }
    }
    __syncthreads();
}


__device__ __forceinline__ void gbar(int k, int word = 0) {
    asm volatile("s_waitcnt vmcnt(0)" ::: "memory");
    __syncthreads();
    if (threadIdx.x == 0) {
        const kptr_t kp = kargs(); unsigned* cnt = (unsigned*)(KPTR(unsigned char, 23) + CTL_BAR) + word;
        __builtin_amdgcn_fence(__ATOMIC_RELEASE, "agent");
        asm volatile("s_waitcnt vmcnt(0)" ::: "memory");
        (void)__hip_atomic_fetch_add(cnt, 1u, __ATOMIC_RELAXED, __HIP_MEMORY_SCOPE_AGENT);
        const unsigned target = (unsigned)(k + 1) * gridDim.x;
        unsigned sp = 0u;
        while (__hip_atomic_load(cnt, __ATOMIC_RELAXED, __HIP_MEMORY_SCOPE_AGENT) < target) { __builtin_amdgcn_s_sleep(1); if (++sp > (1u << 24)) break; }
        __builtin_amdgcn_fence(__ATOMIC_ACQUIRE, "agent");
        asm volatile("s_waitcnt vmcnt(0)" ::: "memory");
    }
    __syncthreads();
}
#ifdef PROBE_SYNC
#define GSYNC(j) do { gbar(2 * (L * 11 + (j))); gbar(2 * (L * 11 + (j)) + 1); } while (0)
#else
__device__ __forceinline__ void xbar(LAS unsigned char* lds) {
    const kptr_t kp = kargs(); XcdBarrier b; b.bar = (unsigned*)(KPTR(unsigned char, 23) + CTL_XBAR); b.x = xb_xcc_id(); b.st = (volatile LAS unsigned*)(lds + LDS_BARST);
    xcd_barrier(b);
}
#define GSYNC(j) xbar(lds)
#endif
template <int L> __device__ __forceinline__ void layer_fwd(cg::grid_group& grid, LAS unsigned char* lds) {
    constexpr int Mr = (L == 0) ? MALL : MX;
    constexpr size_t WL = WS_W + (size_t)L * W_LAYER, MODL = CTL_MOD + (size_t)L * 3 * 9216 * 4, STL = CTL_STATS + (size_t)L * MALL * 2 * 4;
    { PH_BEGIN(); modpass(L == 0 ? KIN(0) : KOUT(), (const float*)(ws + WS_XC), (const float*)(ws + MODL), KIN(6) + (size_t)(L * 3 + 0) * D, 0, (bf16_t*)(ws + WS_H), MALL, gw, NGW, lane); }
    GSYNC(0);
    { PH_BEGIN(); run_gemm(lds, (const bf16_t*)(ws + WS_H), (const bf16_t*)(ws + WL + W_UP1), MALL, 2 * DFF, D, pg8::EpiSwiGLU{(bf16_t*)(ws + WS_G)}); }
    GSYNC(1);
    { PH_BEGIN(); run_gemm(lds, (const bf16_t*)(ws + WS_G), (const bf16_t*)(ws + WL + W_DN1), MX, D, DFF,
                           pg8::EpiResid{L == 0 ? KIN(0) : KOUT(), (const float*)(ws + WS_XC), KOUT(), (float*)(ws + WS_XC), (const float*)(ws + MODL) + 2 * 1024, 0.5f}); }
    { PH_BEGIN(); ctx_resid_gemm((const bf16_t*)(ws + WS_G), (const bf16_t*)(ws + WL + W_DN1), DFF, (float*)(ws + WS_XC), (const float*)(ws + MODL) + 2 * 9216 + 2 * 1024, 0.5f, gw, NGW, lane); }
    GSYNC(2);
    { PH_BEGIN(); modpass(KOUT(), (const float*)(ws + WS_XC), (const float*)(ws + MODL), KIN(6) + (size_t)(L * 3 + 1) * D, 1, (bf16_t*)(ws + WS_H), MALL, gw, NGW, lane); }
    GSYNC(3);
    { PH_BEGIN(); run_gemm(lds, (const bf16_t*)(ws + WS_H), (const bf16_t*)(ws + WL + W_IN), MALL, INC, D,
                           pg8::EpiWin{(bf16_t*)(ws + WS_QU), (bf16_t*)(ws + WS_KB), (bf16_t*)(ws + WS_VT), (bf16_t*)(ws + WS_VST), (bf16_t*)(ws + WS_GT), KIN(10) + (size_t)L * 2048,
                                       (const f32x4*)(ws + CTL_ROPE), (const f32x4*)(ws + CTL_ROPE) + 256 * 8, (float*)(ws + STL), QSCALE, lds + 131072}); }
    GSYNC(4);
#ifdef PROBE_ATTN
    constexpr int NREP_ATTN = 2;
#else
    constexpr int NREP_ATTN = 1;
#endif
#pragma unroll 1
    for (int rep = 0; rep < NREP_ATTN; ++rep) { PH_BEGIN();
        if (rep > 0) gbar(L, 64);
        unsigned* cnt_attn = (unsigned*)(ws + CTL_CNT) + 64 * (2 * L) + 256 * rep;
        { const float* rg = KIN(11) + (size_t)L * 8 * 465; for (int i = threadIdx.x; i < 8 * 465; i += NTHREADS) ((LAS float*)(lds + LDS_RPB))[i] = rg[i] * LOG2E; }
        __syncthreads();
        const bf16_t* KBp = (const bf16_t*)(ws + WS_KB); const bf16_t* VTp = (const bf16_t*)(ws + WS_VT); const bf16_t* QUp = (const bf16_t*)(ws + WS_QU); bf16_t* OBp = (bf16_t*)(ws + WS_H);
        const LAS float* rpbl = (const LAS float*)(lds + LDS_RPB); LAS unsigned char* otl = lds + LDS_OT + wave * 2048;
        const int lw = (blockIdx.x >> 3) * 8 + wave, xcd = blockIdx.x & 7, hp = (blockIdx.x >> 3) & 3;
#pragma unroll 1
        for (int s = 0; s < 10; ++s) {
            const int bb = s / 5, k = s - 5 * bb;
            int u, hs;
            if (k == 0) {
                __syncthreads();
                const int h0 = hp * 2; int tid = threadIdx.x; asm volatile("" : "+v"(tid));
#pragma unroll
                for (int i = 0; i < 8; ++i) { const int ca = tid + 512 * i, hq = ca >> 11, ci = ca & 2047, key = ci >> 3, c = ci & 7;
                    const u32x4 v = *(const u32x4*)(KBp + ((size_t)(h0 + hq) * MALL + (MX + bb * 256 + key)) * 64 + c * 8);
                    *(LAS u32x4*)(lds + LDS_CK + hq * 32768 + key * 128 + ((c ^ ((((key >> 3) & 3) * 2) + ((key >> 1) & 1))) << 4)) = v; }
#pragma unroll
                for (int i = 0; i < 8; ++i) { const int ca = tid + 512 * i, hq = ca >> 11, ci = ca & 2047, blk = ci >> 6, d = ci & 63;
                    const u32x4 v = *(const u32x4*)(VTp + ((size_t)(((MX + bb * 256) >> 3) + blk) * 512 + (h0 + hq) * 64 + d) * 8);
                    *(LAS u32x4*)(lds + LDS_CV + hq * 32768 + d * 512 + ((blk ^ (d & 15)) << 4)) = v; }
                __syncthreads();
            }
            if (k < 4) { const int pair = (bb * 4 + k) * 8 + (lw >> 5), rr = 32 * xcd + (pair & 31); u = (bb << 13) | (rr << 5) | (lw & 31); hs = wave >> 2; }
            else {
                if (L != 0 || xcd >= 4 || wave != 0) continue;
                const int idx = xcd * 8 + (blockIdx.x >> 5); hs = idx >> 4;
                u = 16384 + (bb << 7) + (((idx >> 2) & 3) << 5) + ((hp * 2 + hs) << 2) + (idx & 3);
            }
            attn_unit(u, KBp, VTp, QUp, OBp, rpbl, otl, lds + LDS_CK + hs * 32768, lds + LDS_CV + hs * 32768, lane);
        }
    }
    { PH_BEGIN();
        unsigned* cnt_sg = (unsigned*)(ws + CTL_CNT) + 64 * (2 * L + 1);
        const bf16_t* VSTp = (const bf16_t*)(ws + WS_VST); const bf16_t* QUp = (const bf16_t*)(ws + WS_QU); bf16_t* OBp = (bf16_t*)(ws + WS_H); const float* stp = (const float*)(ws + STL); const bf16_t* wsb = (const bf16_t*)(ws + WL + W_S);
        for (int u = gw; u < 2048; u += NGW) sg_unit<4>(u >> 3, (u >> 1) & 3, (u & 1) * 64, VSTp, QUp, OBp, stp, KIN(12) + L * 512, KIN(13) + L * 512, wsb, KIN(15) + L * 512, lane);
        if (L == 0)
            for (;;) { const int u = wq_next(cnt_sg, lane); if (u >= 64) break; sg_unit<2>(256 + (u >> 4), (u >> 2) & 3, (u & 3) * 32, VSTp, QUp, OBp, stp, KIN(12) + L * 512, KIN(13) + L * 512, wsb, KIN(15) + L * 512, lane); }
    }
    GSYNC(5);
    { PH_BEGIN(); run_gemm(lds, (const bf16_t*)(ws + WS_H), (const bf16_t*)(ws + WL + W_PAB), Mr, 2048, D, pg8::EpiMerge{(const bf16_t*)(ws + WS_GT), (bf16_t*)(ws + WS_MRG)}); }
    GSYNC(6);
    { PH_BEGIN(); run_gemm(lds, (const bf16_t*)(ws + WS_MRG), (const bf16_t*)(ws + WL + W_O), MX, D, D,
                           pg8::EpiResid{KOUT(), (const float*)(ws + WS_XC), KOUT(), (float*)(ws + WS_XC), (const float*)(ws + MODL) + 5 * 1024, 1.0f}); }
    if (L == 0) { PH_BEGIN(); ctx_resid_gemm((const bf16_t*)(ws + WS_MRG), (const bf16_t*)(ws + WL + W_O), D, (float*)(ws + WS_XC), (const float*)(ws + MODL) + 2 * 9216 + 5 * 1024, 1.0f, gw, NGW, lane); }
    GSYNC(7);
    { PH_BEGIN(); modpass(KOUT(), (const float*)(ws + WS_XC), (const float*)(ws + MODL), KIN(6) + (size_t)(L * 3 + 2) * D, 2, (bf16_t*)(ws + WS_H), Mr, gw, NGW, lane); }
    GSYNC(8);
    { PH_BEGIN(); run_gemm(lds, (const bf16_t*)(ws + WS_H), (const bf16_t*)(ws + WL + W_UP2), Mr, 2 * DFF, D, pg8::EpiSwiGLU{(bf16_t*)(ws + WS_G)}); }
    GSYNC(9);
    { PH_BEGIN(); run_gemm(lds, (const bf16_t*)(ws + WS_G), (const bf16_t*)(ws + WL + W_DN2), MX, D, DFF,
                           pg8::EpiResid{KOUT(), (const float*)(ws + WS_XC), KOUT(), (float*)(ws + WS_XC), (const float*)(ws + MODL) + 8 * 1024, 0.5f}); }
    if (L == 0) { PH_BEGIN(); ctx_resid_gemm((const bf16_t*)(ws + WS_G), (const bf16_t*)(ws + WL + W_DN2), DFF, (float*)(ws + WS_XC), (const float*)(ws + MODL) + 2 * 9216 + 8 * 1024, 0.5f, gw, NGW, lane); }
    GSYNC(10);
}

__global__ void __launch_bounds__(NTHREADS, 2) mega_fwd(Args a) {
    extern __shared__ __attribute__((aligned(16))) unsigned char lds_raw[];
    cg::grid_group grid = cg::this_grid();
    LAS unsigned char* lds = (LAS unsigned char*)lds_raw;
    if (threadIdx.x < 2) ((volatile LAS unsigned*)(lds + LDS_BARST))[threadIdx.x] = 0u;
    __syncthreads();
    { const kptr_t kp = kargs(); (void)xcd_barrier_post((unsigned*)(KPTR(unsigned char, 23) + CTL_XBAR), (volatile LAS unsigned*)(lds + LDS_BARST)); }
    { PH_BEGIN(); prologue(kp, (LAS float*)(lds + wave * 16384), gw, NGW, lane); }
    if (gridDim.y == 0x7fffffffu) grid.sync();
    xbar(lds);
    layer_fwd<0>(grid, lds);
    layer_fwd<1>(grid, lds);
    { PH_BEGIN(); final_norm(KOUT(), KIN(21), gw, NGW, lane); }
}

extern "C" void kernel_launch(void* const* d_in, const int* in_sizes, int n_in, void* d_out, int out_size, void* d_ws, size_t ws_size, hipStream_t stream) {
    static int grid = 0;
    if (grid == 0) {
        if (n_in != 22 || out_size != MX * D || ws_size < WS_END) { fprintf(stderr, "kernel_launch: unexpected problem (n_in %d, out %d, ws %zu)\n", n_in, out_size, ws_size); grid = -1; return; }
        int dev = 0, cus = 0, per_cu = 0;
        hipGetDevice(&dev); hipDeviceGetAttribute(&cus, hipDeviceAttributeMultiprocessorCount, dev);
        if (hipFuncSetAttribute((const void*)mega_fwd, hipFuncAttributeMaxDynamicSharedMemorySize, LDS_BYTES) != hipSuccess) { fprintf(stderr, "kernel_launch: hipFuncSetAttribute failed\n"); grid = -1; return; }
        if (hipOccupancyMaxActiveBlocksPerMultiprocessor(&per_cu, (const void*)mega_fwd, NTHREADS, LDS_BYTES) != hipSuccess || per_cu < 1) { fprintf(stderr, "kernel_launch: occupancy query gave %d\n", per_cu); per_cu = 1; }
        (void)hipGetLastError();
        grid = cus * per_cu;
        if (grid != 256) { fprintf(stderr, "kernel_launch: this kernel is built for exactly 256 co-resident workgroups (256 CUs x 1), got %d; nothing launched\n", grid); grid = -1; return; }
        fprintf(stderr, "kernel_launch: grid %d (cus %d x %d)\n", grid, cus, per_cu);
    }
    if (grid < 0) return;
    hipMemsetAsync((char*)d_ws, 0, CTL_BYTES, stream);
    Args a{};
    for (int i = 0; i < 22; ++i) a.in[i] = (const float*)d_in[i];
    a.out = (float*)d_out; a.ws = (unsigned char*)d_ws;
    void* args[] = {&a};
    hipError_t e = hipLaunchCooperativeKernel((const void*)mega_fwd, dim3(grid), dim3(NTHREADS), args, LDS_BYTES, stream);
    if (e != hipSuccess) fprintf(stderr, "cooperative launch failed: %s (grid %d)\n", hipGetErrorString(e), grid);
}
```
